# Optimizing an MI355X kernel written in HIP

```python
import math
import jax
import jax.numpy as jnp
from jax import lax
import numpy as np

D_MODEL = 1024
BATCH = 2
SEQ = 8192
DEPTH = 2

HEAD_DIM = 64
D_MIX = D_MODEL
M_HEADS = 4
M_CHUNK = 64
G_HEADS = 4
G_CHUNK = 64
CONV_K = 4
N_HEADS = 8
N_KV_HEADS = 2
N_GROUP = N_HEADS // N_KV_HEADS
CMP_BLOCK = 32
CMP_STRIDE = 16
CMP_HIDDEN = 256
SLC_BLOCK = 64
N_SELECTED = 16
WINDOW = 512
Q_BLOCK = 128
ROPE_THETA = 10000.0
D_FF = 2816
EPS = 1e-6
NEG = -1e30
BIG = 1e30

M_WIDTH = M_HEADS * HEAD_DIM
G_WIDTH = G_HEADS * HEAD_DIM
N_WIDTH = N_HEADS * HEAD_DIM
KV_WIDTH = N_KV_HEADS * HEAD_DIM
M_IN = 4 * M_WIDTH + 2 * M_HEADS
G_IN = 4 * G_WIDTH + 2 * G_HEADS
N_IN = N_WIDTH + 6 * KV_WIDTH + 3 * N_HEADS
IN_WIDTH = M_IN + G_IN + N_IN

kernel_name = 'hybrid_mlstm_gdn_nsa_macaron'


def rms_norm(x, w):
    xf = x.astype(jnp.float32)
    y = xf * lax.rsqrt(jnp.mean(xf * xf, axis=-1, keepdims=True) + EPS)
    return y * w.astype(jnp.float32)


def l2_normalize(x):
    return x * lax.rsqrt(jnp.sum(x * x, axis=-1, keepdims=True) + EPS)


def rope(x, pos):
    half = HEAD_DIM // 2
    inv_freq = jnp.power(ROPE_THETA, -jnp.arange(half, dtype=jnp.float32) / half)
    ang = pos.astype(jnp.float32)[:, None] * inv_freq[None, :]
    cos, sin = jnp.cos(ang), jnp.sin(ang)
    x1, x2 = x[..., :half], x[..., half:]
    return jnp.concatenate([x1 * cos - x2 * sin, x1 * sin + x2 * cos], axis=-1)


def to_heads(x, n_heads):
    b, t, _ = x.shape
    return x.reshape(b, t, n_heads, HEAD_DIM).transpose(0, 2, 1, 3)


def from_heads(x):
    b, h, t, d = x.shape
    return x.transpose(0, 2, 1, 3).reshape(b, t, h * d)


def adaln(x, w, shift, scale):
    return (rms_norm(x, w) * (1.0 + scale) + shift).astype(x.dtype)


def swiglu(h, w_up, w_down):
    gate, up = jnp.split(h @ w_up, 2, axis=-1)
    return (jax.nn.silu(gate) * up) @ w_down


def mlstm_group(p, gate_b, norm_w):
    b, t, _ = p.shape
    nc = t // M_CHUNK
    w = M_WIDTH
    q = to_heads(p[..., 0:w], M_HEADS) * (HEAD_DIM ** -0.5)
    k = to_heads(p[..., w:2 * w], M_HEADS)
    v = to_heads(p[..., 2 * w:3 * w], M_HEADS)
    o_gate = jax.nn.sigmoid(p[..., 3 * w:4 * w])
    gates = p[..., 4 * w:] + gate_b.reshape(-1)
    log_i = gates[..., :M_HEADS].transpose(0, 2, 1)
    log_f = jax.nn.log_sigmoid(gates[..., M_HEADS:]).transpose(0, 2, 1)
    ch = lambda a: a.reshape(b, M_HEADS, nc, M_CHUNK, *a.shape[3:])
    q, k, v, log_i, log_f = ch(q), ch(k), ch(v), ch(log_i), ch(log_f)
    cum = jnp.cumsum(log_f, axis=-1)
    g_tot = cum[..., -1]
    a = g_tot[..., None] - cum + log_i
    m_loc = jnp.max(a, axis=-1)
    wgt = jnp.exp(a - m_loc[..., None])
    c_loc = jnp.einsum('bhcl,bhcld,bhcle->bhcde', wgt, k, v)
    n_loc = jnp.einsum('bhcl,bhcld->bhcd', wgt, k)

    def step(carry, inp):
        c_st, n_st, m_st = carry
        g_c, m_l, c_l, n_l = inp
        m_new = jnp.maximum(g_c + m_st, m_l)
        s_old = jnp.exp(g_c + m_st - m_new)
        s_new = jnp.exp(m_l - m_new)
        c_next = s_old[..., None, None] * c_st + s_new[..., None, None] * c_l
        n_next = s_old[..., None] * n_st + s_new[..., None] * n_l
        return (c_next, n_next, m_new), (c_st, n_st, m_st)

    init = (jnp.zeros((b, M_HEADS, HEAD_DIM, HEAD_DIM), jnp.float32),
            jnp.zeros((b, M_HEADS, HEAD_DIM), jnp.float32),
            jnp.zeros((b, M_HEADS), jnp.float32))
    xs = (jnp.moveaxis(g_tot, 2, 0), jnp.moveaxis(m_loc, 2, 0),
          jnp.moveaxis(c_loc, 2, 0), jnp.moveaxis(n_loc, 2, 0))
    _, (c_prev, n_prev, m_prev) = lax.scan(step, init, xs)
    c_prev = jnp.moveaxis(c_prev, 0, 2)
    n_prev = jnp.moveaxis(n_prev, 0, 2)
    m_prev = jnp.moveaxis(m_prev, 0, 2)

    causal = jnp.tril(jnp.ones((M_CHUNK, M_CHUNK), dtype=bool))
    d = jnp.where(causal, cum[..., :, None] - cum[..., None, :] + log_i[..., None, :], -jnp.inf)
    m_inter = cum + m_prev[..., None]
    m_t = jnp.maximum(m_inter, jnp.max(d, axis=-1))
    s = jnp.einsum('bhctd,bhcjd->bhctj', q, k) * jnp.exp(d - m_t[..., None])
    inter = jnp.exp(m_inter - m_t)
    num = (jnp.einsum('bhctj,bhcje->bhcte', s, v)
           + inter[..., None] * jnp.einsum('bhctd,bhcde->bhcte', q, c_prev))
    den = jnp.sum(s, axis=-1) + inter * jnp.einsum('bhctd,bhcd->bhct', q, n_prev)
    den = jnp.maximum(jnp.abs(den), jnp.exp(-m_t))
    h = (num / den[..., None]).reshape(b, M_HEADS, t, HEAD_DIM)
    return o_gate * from_heads(rms_norm(h, norm_w))


def causal_depthwise_conv(x, w):
    c = x.shape[-1]
    return lax.conv_general_dilated(x, w[:, None, :], window_strides=(1,), padding=[(CONV_K - 1, 0)],
                                    dimension_numbers=('NWC', 'WIO', 'NWC'), feature_group_count=c)


def gdn_group(p, conv_w, a_log, dt_bias, norm_w):
    b, t, _ = p.shape
    nc = t // G_CHUNK
    w = G_WIDTH
    qkv = jax.nn.silu(causal_depthwise_conv(p[..., :3 * w], conv_w.astype(jnp.float32)))
    q = l2_normalize(to_heads(qkv[..., :w], G_HEADS)) * (HEAD_DIM ** -0.5)
    k = l2_normalize(to_heads(qkv[..., w:2 * w], G_HEADS))
    v = to_heads(qkv[..., 2 * w:3 * w], G_HEADS)
    z = p[..., 3 * w:4 * w]
    a_pre = p[..., 4 * w:4 * w + G_HEADS].transpose(0, 2, 1)
    beta = jax.nn.sigmoid(p[..., 4 * w + G_HEADS:]).transpose(0, 2, 1)
    log_alpha = -jnp.exp(a_log.astype(jnp.float32))[None, :, None] * jax.nn.softplus(a_pre + dt_bias[None, :, None])
    ch = lambda a: a.reshape(b, G_HEADS, nc, G_CHUNK, *a.shape[3:])
    q, k, v, beta, log_alpha = ch(q), ch(k), ch(v), ch(beta), ch(log_alpha)
    gam = jnp.cumsum(log_alpha, axis=-1)
    idx = jnp.arange(G_CHUNK)
    strict = idx[:, None] > idx[None, :]
    incl = idx[:, None] >= idx[None, :]
    diff = gam[..., :, None] - gam[..., None, :]
    kk = jnp.einsum('bhctd,bhcjd->bhctj', k, k)
    a_mat = beta[..., None] * kk * jnp.exp(jnp.where(strict, diff, -jnp.inf))
    eye = jnp.eye(G_CHUNK, dtype=jnp.float32)
    rhs = jnp.concatenate([beta[..., None] * v, (beta * jnp.exp(gam))[..., None] * k], axis=-1)
    sol = lax.linalg.triangular_solve(eye + a_mat, rhs, left_side=True, lower=True, unit_diagonal=True)
    u0, w_mat = sol[..., :HEAD_DIM], sol[..., HEAD_DIM:]
    p_mat = jnp.einsum('bhctd,bhcjd->bhctj', q, k) * jnp.exp(jnp.where(incl, diff, -jnp.inf))
    q_g = q * jnp.exp(gam)[..., None]
    k_d = k * jnp.exp(gam[..., -1:] - gam)[..., None]
    g_last = jnp.exp(gam[..., -1])

    def step(s, inp):
        u0_c, w_c, qg_c, p_c, kd_c, gl_c = inp
        u = u0_c - jnp.einsum('bhld,bhde->bhle', w_c, s)
        o = jnp.einsum('bhld,bhde->bhle', qg_c, s) + jnp.einsum('bhlj,bhje->bhle', p_c, u)
        s_next = gl_c[..., None, None] * s + jnp.einsum('bhld,bhle->bhde', kd_c, u)
        return s_next, o

    xs = (jnp.moveaxis(u0, 2, 0), jnp.moveaxis(w_mat, 2, 0), jnp.moveaxis(q_g, 2, 0),
          jnp.moveaxis(p_mat, 2, 0), jnp.moveaxis(k_d, 2, 0), jnp.moveaxis(g_last, 2, 0))
    _, o = lax.scan(step, jnp.zeros((b, G_HEADS, HEAD_DIM, HEAD_DIM), jnp.float32), xs)
    o = jnp.moveaxis(o, 0, 2).reshape(b, G_HEADS, t, HEAD_DIM)
    return from_heads(rms_norm(o, norm_w)) * jax.nn.silu(z)


def compress(blocks, pos_emb, w1, w2):
    b, h, n = blocks.shape[:3]
    flat = (blocks + pos_emb).reshape(b, h, n, CMP_BLOCK * HEAD_DIM)
    return jax.nn.silu(flat @ w1) @ w2


def nsa_group(p, qk_norm, cmp_pos, cmp_w1, cmp_w2):
    b, t, _ = p.shape
    scale = HEAD_DIM ** -0.5
    pos = jnp.arange(t, dtype=jnp.int32)
    q = rope(rms_norm(to_heads(p[..., :N_WIDTH], N_HEADS), qk_norm[0]), pos)
    kv = p[..., N_WIDTH:N_WIDTH + 6 * KV_WIDTH]
    k_cmp, v_cmp, k_slc, v_slc, k_win, v_win = [
        to_heads(kv[..., i * KV_WIDTH:(i + 1) * KV_WIDTH], N_KV_HEADS) for i in range(6)]
    gates = jax.nn.sigmoid(p[..., N_WIDTH + 6 * KV_WIDTH:])
    k_slc = rope(rms_norm(k_slc, qk_norm[2]), pos)
    k_win = rope(rms_norm(k_win, qk_norm[3]), pos)

    n_cmp = (t - CMP_BLOCK) // CMP_STRIDE + 1
    cmp_start = jnp.arange(n_cmp) * CMP_STRIDE
    cmp_idx = cmp_start[:, None] + jnp.arange(CMP_BLOCK)[None, :]
    cmp_end = cmp_start + CMP_BLOCK - 1
    kc = compress(k_cmp[:, :, cmp_idx], cmp_pos[0], cmp_w1[0], cmp_w2[0])
    kc = rope(rms_norm(kc, qk_norm[1]), cmp_end)
    vc = compress(v_cmp[:, :, cmp_idx], cmp_pos[1], cmp_w1[1], cmp_w2[1])

    n_slc = t // SLC_BLOCK
    n_sel = min(N_SELECTED, n_slc)
    ks_blocks = k_slc.reshape(b, N_KV_HEADS, n_slc, SLC_BLOCK, HEAD_DIM)
    vs_blocks = v_slc.reshape(b, N_KV_HEADS, n_slc, SLC_BLOCK, HEAD_DIM)
    slc_start = jnp.arange(n_slc) * SLC_BLOCK
    overlap = jnp.maximum(jnp.minimum(cmp_start[:, None] + CMP_BLOCK, slc_start[None, :] + SLC_BLOCK)
                          - jnp.maximum(cmp_start[:, None], slc_start[None, :]), 0).astype(jnp.float32) / CMP_BLOCK

    kw_pad = jnp.pad(k_win, ((0, 0), (0, 0), (WINDOW, 0), (0, 0)))
    vw_pad = jnp.pad(v_win, ((0, 0), (0, 0), (WINDOW, 0), (0, 0)))

    n_qb = t // Q_BLOCK
    q_blocks = jnp.moveaxis(q.reshape(b, N_KV_HEADS, N_GROUP, n_qb, Q_BLOCK, HEAD_DIM), 3, 0)
    g_blocks = gates.reshape(b, t, 3, N_KV_HEADS, N_GROUP).transpose(0, 3, 4, 1, 2)
    g_blocks = jnp.moveaxis(g_blocks.reshape(b, N_KV_HEADS, N_GROUP, n_qb, Q_BLOCK, 3), 3, 0)
    starts = jnp.arange(n_qb, dtype=jnp.int32) * Q_BLOCK
    bi = jnp.arange(b)[:, None, None, None]
    hi = jnp.arange(N_KV_HEADS)[None, :, None, None]
    blk = jnp.arange(n_slc)
    tok = jnp.arange(SLC_BLOCK)
    win_off = jnp.arange(Q_BLOCK + WINDOW)

    def attend_block(args):
        qb, gb, start = args
        tq = start + jnp.arange(Q_BLOCK)
        s_c = jnp.einsum('bhgqd,bhnd->bhgqn', qb, kc) * scale
        valid_c = cmp_end[None, :] <= tq[:, None]
        p_c = jax.nn.softmax(jnp.where(valid_c, s_c, NEG), axis=-1)
        p_c = p_c * jnp.any(valid_c, axis=-1)[:, None].astype(jnp.float32)
        o_c = jnp.einsum('bhgqn,bhnd->bhgqd', p_c, vc)
        imp = jnp.einsum('bhgqn,ns->bhqs', p_c, overlap)
        cur = tq // SLC_BLOCK
        forced = (blk[None, :] == 0) | (blk[None, :] == cur[:, None]) | (blk[None, :] == cur[:, None] - 1)
        imp = jnp.where(forced, BIG, imp)
        imp = jnp.where(slc_start[None, :] <= tq[:, None], imp, NEG)
        _, sel = lax.top_k(imp, n_sel)
        ks = ks_blocks[bi, hi, sel]
        vs = vs_blocks[bi, hi, sel]
        s_s = jnp.einsum('bhgqd,bhqnpd->bhgqnp', qb, ks) * scale
        tok_pos = sel[..., None] * SLC_BLOCK + tok
        valid_s = (tok_pos <= tq[:, None, None])[:, :, None]
        s_s = jnp.where(valid_s, s_s, NEG).reshape(b, N_KV_HEADS, N_GROUP, Q_BLOCK, n_sel * SLC_BLOCK)
        p_s = jax.nn.softmax(s_s, axis=-1).reshape(b, N_KV_HEADS, N_GROUP, Q_BLOCK, n_sel, SLC_BLOCK)
        o_s = jnp.einsum('bhgqnp,bhqnpd->bhgqd', p_s, vs)
        kw = lax.dynamic_slice_in_dim(kw_pad, start, Q_BLOCK + WINDOW, axis=2)
        vw = lax.dynamic_slice_in_dim(vw_pad, start, Q_BLOCK + WINDOW, axis=2)
        kpos = start - WINDOW + win_off
        dist = tq[:, None] - kpos[None, :]
        valid_w = (dist >= 0) & (dist < WINDOW) & (kpos[None, :] >= 0)
        s_w = jnp.einsum('bhgqd,bhkd->bhgqk', qb, kw) * scale
        p_w = jax.nn.softmax(jnp.where(valid_w, s_w, NEG), axis=-1)
        o_w = jnp.einsum('bhgqk,bhkd->bhgqd', p_w, vw)
        return gb[..., 0:1] * o_c + gb[..., 1:2] * o_s + gb[..., 2:3] * o_w

    out = lax.map(attend_block, (q_blocks, g_blocks, starts))
    out = jnp.moveaxis(out, 0, 3).reshape(b, N_HEADS, t, HEAD_DIM)
    return from_heads(out)


def hybrid_mixer(h, w_in, w_out, m_gate_b, m_norm_w, g_conv_w, g_a_log, g_dt_bias, g_norm_w,
                 n_qk_norm, n_cmp_pos, n_cmp_w1, n_cmp_w2):
    proj = (h @ w_in).astype(jnp.float32)
    y_m = mlstm_group(proj[..., :M_IN], m_gate_b, m_norm_w)
    y_g = gdn_group(proj[..., M_IN:M_IN + G_IN], g_conv_w, g_a_log, g_dt_bias, g_norm_w)
    y_n = nsa_group(proj[..., M_IN + G_IN:], n_qk_norm, n_cmp_pos, n_cmp_w1, n_cmp_w2)
    y = jnp.concatenate([y_m, y_g, y_n], axis=-1).astype(h.dtype)
    return y @ w_out


def setup_inputs(seed: int = 0) -> dict:
    key = jax.random.key(seed)
    ks = jax.random.split(key, 20)
    f32 = jnp.float32
    nrm = lambda k, shape, s: jax.random.normal(k, shape, f32) * s
    x = nrm(ks[0], (BATCH, SEQ, D_MODEL), 1.0)
    c = nrm(ks[1], (BATCH, D_MODEL), 1.0)
    ada_w = nrm(ks[2], (DEPTH, D_MODEL, 9 * D_MODEL), 0.5 * D_MODEL ** -0.5)
    ada_b = nrm(ks[3], (DEPTH, 9 * D_MODEL), 0.01)
    norm_w = 1.0 + nrm(ks[4], (DEPTH, 3, D_MODEL), 0.02)
    ffn_w_up = nrm(ks[5], (DEPTH, 2, D_MODEL, 2 * D_FF), D_MODEL ** -0.5)
    ffn_w_down = nrm(ks[6], (DEPTH, 2, D_FF, D_MODEL), D_FF ** -0.5)
    w_in = nrm(ks[7], (DEPTH, D_MODEL, IN_WIDTH), D_MODEL ** -0.5)
    w_out = nrm(ks[8], (DEPTH, D_MIX, D_MODEL), D_MIX ** -0.5)
    i_b = nrm(ks[9], (DEPTH, 1, M_HEADS), 0.01)
    f_b = 3.0 + nrm(ks[10], (DEPTH, 1, M_HEADS), 0.1)
    mlstm_gate_b = jnp.concatenate([i_b, f_b], axis=1)
    mlstm_norm_w = 1.0 + nrm(ks[11], (DEPTH, HEAD_DIM), 0.02)
    gdn_conv_w = nrm(ks[12], (DEPTH, CONV_K, 3 * G_WIDTH), CONV_K ** -0.5)
    gdn_a_log = jnp.log(jax.random.uniform(ks[13], (DEPTH, G_HEADS), f32, 1.0, 16.0))
    dt = jnp.exp(jax.random.uniform(ks[14], (DEPTH, G_HEADS), f32, math.log(1e-3), math.log(1e-1)))
    gdn_dt_bias = dt + jnp.log(-jnp.expm1(-dt))
    gdn_norm_w = 1.0 + nrm(ks[15], (DEPTH, HEAD_DIM), 0.02)
    nsa_qk_norm = 1.0 + nrm(ks[16], (DEPTH, 4, HEAD_DIM), 0.02)
    nsa_cmp_pos = nrm(ks[17], (DEPTH, 2, CMP_BLOCK, HEAD_DIM), 0.02)
    nsa_cmp_w1 = nrm(ks[18], (DEPTH, 2, CMP_BLOCK * HEAD_DIM, CMP_HIDDEN), (CMP_BLOCK * HEAD_DIM) ** -0.5)
    nsa_cmp_w2 = nrm(ks[19], (DEPTH, 2, CMP_HIDDEN, HEAD_DIM), CMP_HIDDEN ** -0.5)
    return {'x': x, 'c': c, 'ada_w': ada_w, 'ada_b': ada_b, 'norm_w': norm_w,
            'ffn_w_up': ffn_w_up, 'ffn_w_down': ffn_w_down, 'w_in': w_in, 'w_out': w_out,
            'mlstm_gate_b': mlstm_gate_b, 'mlstm_norm_w': mlstm_norm_w,
            'gdn_conv_w': gdn_conv_w, 'gdn_a_log': gdn_a_log, 'gdn_dt_bias': gdn_dt_bias,
            'gdn_norm_w': gdn_norm_w, 'nsa_qk_norm': nsa_qk_norm, 'nsa_cmp_pos': nsa_cmp_pos,
            'nsa_cmp_w1': nsa_cmp_w1, 'nsa_cmp_w2': nsa_cmp_w2}


def reference(x, c, ada_w, ada_b, norm_w, ffn_w_up, ffn_w_down, w_in, w_out,
              mlstm_gate_b, mlstm_norm_w, gdn_conv_w, gdn_a_log, gdn_dt_bias, gdn_norm_w,
              nsa_qk_norm, nsa_cmp_pos, nsa_cmp_w1, nsa_cmp_w2):
    b = x.shape[0]
    c_act = jax.nn.silu(c)
    for l in range(DEPTH):
        mod = (c_act @ ada_w[l] + ada_b[l]).reshape(b, 9, 1, D_MODEL)
        h = adaln(x, norm_w[l, 0], mod[:, 0], mod[:, 1])
        x = x + 0.5 * mod[:, 2] * swiglu(h, ffn_w_up[l, 0], ffn_w_down[l, 0])
        h = adaln(x, norm_w[l, 1], mod[:, 3], mod[:, 4])
        x = x + mod[:, 5] * hybrid_mixer(h, w_in[l], w_out[l], mlstm_gate_b[l], mlstm_norm_w[l],
                                         gdn_conv_w[l], gdn_a_log[l], gdn_dt_bias[l], gdn_norm_w[l],
                                         nsa_qk_norm[l], nsa_cmp_pos[l], nsa_cmp_w1[l], nsa_cmp_w2[l])
        h = adaln(x, norm_w[l, 2], mod[:, 6], mod[:, 7])
        x = x + 0.5 * mod[:, 8] * swiglu(h, ffn_w_up[l, 1], ffn_w_down[l, 1])
    return x
```

```cpp
#include <hip/hip_runtime.h>
#include <hip/hip_cooperative_groups.h>
#include <cstdio>
#include <cstdint>
namespace cg = cooperative_groups;

typedef __attribute__((ext_vector_type(8))) short bf16x8;
typedef __attribute__((ext_vector_type(16))) float f32x16;
typedef __attribute__((ext_vector_type(4))) unsigned int u32x4;
typedef unsigned short u16;


#ifndef REP_GEMM
#define REP_GEMM 1
#endif
#ifndef REP_AD
#define REP_AD 1
#endif
#ifndef EXTRA_SYNC
#define EXTRA_SYNC 0
#endif
#ifndef REP_NSA
#define REP_NSA 1
#endif
#ifndef REP_F2
#define REP_F2 1
#endif
#ifndef REP_P0
#define REP_P0 1
#endif
#ifndef REP_F1
#define REP_F1 1
#endif
#ifndef REP_F3
#define REP_F3 1
#endif
#define DEV __device__ __forceinline__

#ifdef NO_GDNPREP
#define SK_GDNPREP(x)
#else
#define SK_GDNPREP(x) x
#endif
#ifdef NO_MLPREP
#define SK_MLPREP(x)
#else
#define SK_MLPREP(x) x
#endif
#ifdef NO_GDNSCAN
#define SK_GDNSCAN(x)
#else
#define SK_GDNSCAN(x) x
#endif
#ifdef NO_NSA
#define SK_NSA(x)
#else
#define SK_NSA(x) x
#endif
#ifdef NO_MLOUT
#define SK_MLOUT(x)
#else
#define SK_MLOUT(x) x
#endif
#ifdef NO_GDNOUT
#define SK_GDNOUT(x)
#else
#define SK_GDNOUT(x) x
#endif


static constexpr int T_ = 8192;
static constexpr int NT_ = 16384;
static constexpr int DM_ = 1024;
static constexpr int DFF_ = 2816;
static constexpr int PW_ = 3456;
static constexpr int INW_ = 3368;
static constexpr int LDS_BYTES = 75776;

static constexpr size_t OFF_HB   = 0;
static constexpr size_t OFF_WT   = 33554432;
static constexpr size_t OFF_MOD  = OFF_WT + 17301504;
static constexpr size_t OFF_B1   = OFF_MOD + 147456;
static constexpr size_t OFF_BAR  = OFF_MOD + 163840;
static constexpr size_t OFF_R    = OFF_MOD + 262144;
static constexpr size_t OFF_ACT  = OFF_R;
static constexpr size_t OFF_PROJ = OFF_R;
static constexpr size_t OFF_SIDE = OFF_PROJ + 113246208;
static constexpr size_t OFF_MLSV = OFF_SIDE + 2621440;
static constexpr size_t OFF_MLKV = OFF_MLSV + 16777216;
static constexpr size_t OFF_MLVEC= OFF_MLKV + 16777216;
static constexpr size_t OFF_GDM  = OFF_MLVEC + 1310720;
static constexpr size_t OFF_GDB  = OFF_GDM + 16777216;
static constexpr size_t OFF_GDQ  = OFF_GDB + 16777216;
static constexpr size_t OFF_GDP  = OFF_GDQ + 16777216;
static constexpr size_t OFF_QN   = OFF_GDP + 16777216;
static constexpr size_t OFF_KS   = OFF_QN + 16777216;
static constexpr size_t OFF_KW   = OFF_KS + 4194304;
static constexpr size_t OFF_VST  = OFF_KW + 4194304;
static constexpr size_t OFF_VWT  = OFF_VST + 4194304;
static constexpr size_t OFF_HID  = OFF_VWT + 4194304;
static constexpr size_t OFF_KC   = OFF_HID + 2097152;
static constexpr size_t OFF_VCT  = OFF_KC + 262144;
static constexpr size_t OFF_SPREV= OFF_VCT + 262144;
static constexpr size_t OFF_CPREV= OFF_SPREV + 16777216;
static constexpr size_t OFF_NPREV= OFF_CPREV + 16777216;
static constexpr size_t OFF_WTB  = OFF_NPREV + 262144;
static constexpr size_t OFF_WTC  = OFF_WTB + 11272192;
static constexpr size_t OFF_END  = OFF_WTC + 17301504;

static constexpr size_t WT_UP   = 0;
static constexpr size_t WT_DOWN = 11534336;
static constexpr size_t WT_IN   = 0;
static constexpr size_t WT_OUT  = 7077888;
static constexpr size_t WT_W1   = 7077888 + 2097152;

struct Params {
  const float* in[19];
  float* out;
  unsigned char* ws;
};

DEV u16 f2bf(float f) {
  uint32_t u = __float_as_uint(f);
  u += 0x7fffu + ((u >> 16) & 1u);
  return (u16)(u >> 16);
}
DEV int opaque_tid() { int t = threadIdx.x; asm volatile("" : "+v"(t)); return t; }
DEV float bf2f(u16 h) { return __uint_as_float(((uint32_t)h) << 16); }
DEV uint32_t cvtpk(float lo, float hi) { uint32_t r; asm("v_cvt_pk_bf16_f32 %0, %1, %2" : "=v"(r) : "v"(lo), "v"(hi)); return r; }
DEV uint32_t pack2(float a, float b) { return (uint32_t)f2bf(a) | ((uint32_t)f2bf(b) << 16); }
DEV float bflo(uint32_t w) { return __uint_as_float(w << 16); }
DEV float bfhi(uint32_t w) { return __uint_as_float(w & 0xffff0000u); }
DEV float sigmoidf_(float x) { return 1.f / (1.f + expf(-x)); }
DEV float siluf_(float x) { return x / (1.f + expf(-x)); }
DEV float wave_sum_lds(float v) {
#pragma unroll
  for (int o = 32; o >= 1; o >>= 1) v += __shfl_xor(v, o);
  return v;
}
DEV float wave_scan_add(float v, int lane) {
#pragma unroll
  for (int o = 1; o < 64; o <<= 1) { const float u = __shfl_up(v, o); if (lane >= o) v += u; }
  return v;
}
DEV float wave_scan_max(float v, int lane) {
#pragma unroll
  for (int o = 1; o < 64; o <<= 1) { const float u = __shfl_up(v, o); if (lane >= o) v = fmaxf(v, u); }
  return v;
}
DEV float dpp_f(float v, const int ctrl_sel) {
  const int iv = __float_as_int(v);
  int r;
  if (ctrl_sel == 0) r = __builtin_amdgcn_update_dpp(iv, iv, 0xB1, 0xF, 0xF, false);
  else if (ctrl_sel == 1) r = __builtin_amdgcn_update_dpp(iv, iv, 0x4E, 0xF, 0xF, false);
  else if (ctrl_sel == 2) r = __builtin_amdgcn_update_dpp(iv, iv, 0x124, 0xF, 0xF, false);
  else r = __builtin_amdgcn_update_dpp(iv, iv, 0x128, 0xF, 0xF, false);
  return __int_as_float(r);
}
DEV float wave_max_valu(float v) {
  typedef __attribute__((ext_vector_type(2))) unsigned u32x2_;
  v = fmaxf(v, dpp_f(v, 0));
  v = fmaxf(v, dpp_f(v, 1));
  v = fmaxf(v, dpp_f(v, 2));
  v = fmaxf(v, dpp_f(v, 3));
  const u32x2_ a = __builtin_amdgcn_permlane16_swap(__float_as_uint(v), __float_as_uint(v), false, false);
  v = fmaxf(__uint_as_float(a[0]), __uint_as_float(a[1]));
  const u32x2_ b = __builtin_amdgcn_permlane32_swap(__float_as_uint(v), __float_as_uint(v), false, false);
  return fmaxf(__uint_as_float(b[0]), __uint_as_float(b[1]));
}
DEV float wave_sum(float v) {
  typedef __attribute__((ext_vector_type(2))) unsigned u32x2_;
  v += dpp_f(v, 0);
  v += dpp_f(v, 1);
  v += dpp_f(v, 2);
  v += dpp_f(v, 3);
  const u32x2_ a = __builtin_amdgcn_permlane16_swap(__float_as_uint(v), __float_as_uint(v), false, false);
  v = __uint_as_float(a[0]) + __uint_as_float(a[1]);
  const u32x2_ b = __builtin_amdgcn_permlane32_swap(__float_as_uint(v), __float_as_uint(v), false, false);
  return __uint_as_float(b[0]) + __uint_as_float(b[1]);
}
DEV float row16_sum(float v) {
  v += dpp_f(v, 0);
  v += dpp_f(v, 1);
  v += dpp_f(v, 2);
  v += dpp_f(v, 3);
  return v;
}
DEV float wave_max(float v) {
#pragma unroll
  for (int o = 32; o >= 1; o >>= 1) v = fmaxf(v, __shfl_xor(v, o));
  return v;
}

DEV void job_mod(const Params& p, int job, float* sm) {
  const int tid = opaque_tid();
  float* mod = (float*)(p.ws + OFF_MOD);
  const int l = job / 144, cgp = job % 144;
  const int col = cgp * 64 + (tid & 63), kp = tid >> 6;
  const float* W = p.in[2] + (size_t)l * 1024 * 9216;
  const float* c = p.in[1];
  float a0 = 0.f, a1 = 0.f;
  float* cs = sm + 512;
  for (int i = tid; i < 2048; i += 256) cs[i] = siluf_(c[i]);
  __syncthreads();
#pragma unroll 16
  for (int k = kp * 256; k < kp * 256 + 256; ++k) {
    const float w = W[(size_t)k * 9216 + col];
    a0 += cs[k] * w; a1 += cs[1024 + k] * w;
  }
  sm[tid] = a0; sm[256 + tid] = a1;
  __syncthreads();
  if (tid < 64) {
    float bb = p.in[3][l * 9216 + col];
    mod[(l * 2 + 0) * 9216 + col] = sm[tid] + sm[tid + 64] + sm[tid + 128] + sm[tid + 192] + bb;
    mod[(l * 2 + 1) * 9216 + col] = sm[256 + tid] + sm[256 + tid + 64] + sm[256 + tid + 128] + sm[256 + tid + 192] + bb;
  }
  __syncthreads();
}

DEV void job_bias1(const Params& p, int job, float* sm) {
  const int tid = opaque_tid();
  float* b1 = (float*)(p.ws + OFF_B1);
  const int lk = job >> 2, cgp = job & 3;
  const int col = cgp * 64 + (tid & 63), kp = tid >> 6;
  const float* W = p.in[17] + (size_t)lk * 2048 * 256;
  const float* pos = p.in[16] + (size_t)lk * 2048;
  float a = 0.f;
#pragma unroll 32
  for (int j = kp * 512; j < kp * 512 + 512; ++j) a += pos[j] * W[(size_t)j * 256 + col];
  sm[tid] = a;
  __syncthreads();
  if (tid < 64) b1[lk * 256 + col] = sm[tid] + sm[tid + 64] + sm[tid + 128] + sm[tid + 192];
  __syncthreads();
}

DEV void job_wt(const float* __restrict__ src, int ldsrc, u16* __restrict__ dst, int Kdst, int k0, int r0, int mode, int nvalid, float* sm) {
  const int tid = opaque_tid();
  const int rr = tid & 63, kk0 = tid >> 6;
  int scol; bool ok = true;
  if (mode == 1) {
    const int nb = r0 >> 7, wn = (r0 >> 6) & 1, s = rr >> 5, cc = rr & 31;
    scol = s * 2816 + 64 * nb + 32 * wn + cc;
  } else { scol = r0 + rr; ok = scol < nvalid; if (!ok) scol = 0; }
#pragma unroll
  for (int i = 0; i < 16; ++i) {
    const int kk = kk0 + 4 * i;
    float v = src[(size_t)(k0 + kk) * ldsrc + scol];
    sm[kk * 65 + rr] = ok ? v : 0.f;
  }
  __syncthreads();
  const int r = tid >> 2, kq = tid & 3;
  uint32_t w[8];
#pragma unroll
  for (int i = 0; i < 8; ++i) w[i] = pack2(sm[(kq * 16 + 2 * i) * 65 + r], sm[(kq * 16 + 2 * i + 1) * 65 + r]);
  uint4* d = (uint4*)(dst + (size_t)(r0 + r) * Kdst + k0 + kq * 16);
  d[0] = make_uint4(w[0], w[1], w[2], w[3]);
  d[1] = make_uint4(w[4], w[5], w[6], w[7]);
  __syncthreads();
}

DEV void job_adaln(const float* __restrict__ x, const float* __restrict__ nw, const float* __restrict__ modl, int sub, u16* __restrict__ hb, int job) {
  const int tid = opaque_tid(), lane = tid & 63, wave = tid >> 6;
  const int row = job * 4 + wave;
  const int b = row >> 13;
  const float* shift = modl + b * 9216 + (3 * sub) * 1024;
  const float* scale = shift + 1024;
  const float4* xr = (const float4*)(x + (size_t)row * 1024);
  float4 v[4]; float ss = 0.f;
#pragma unroll
  for (int i = 0; i < 4; ++i) { v[i] = xr[lane + 64 * i]; ss += v[i].x * v[i].x + v[i].y * v[i].y + v[i].z * v[i].z + v[i].w * v[i].w; }
  float4 n4v[4], scv[4], shv[4];
#pragma unroll
  for (int i = 0; i < 4; ++i) {
    const int k = (lane + 64 * i) * 4;
    n4v[i] = *(const float4*)(nw + k); scv[i] = *(const float4*)(scale + k); shv[i] = *(const float4*)(shift + k);
  }
  __builtin_amdgcn_sched_barrier(0);
  ss = wave_sum(ss);
  const float rstd = rsqrtf(ss * (1.f / 1024.f) + 1e-6f);
#pragma unroll
  for (int i = 0; i < 4; ++i) {
    const int k = (lane + 64 * i) * 4;
    const float4 n4 = n4v[i], sc = scv[i], sh = shv[i];
    float y0 = v[i].x * rstd * n4.x * (1.f + sc.x) + sh.x;
    float y1 = v[i].y * rstd * n4.y * (1.f + sc.y) + sh.y;
    float y2 = v[i].z * rstd * n4.z * (1.f + sc.z) + sh.z;
    float y3 = v[i].w * rstd * n4.w * (1.f + sc.w) + sh.w;
    *(uint2*)(hb + (size_t)row * 1024 + k) = make_uint2(pack2(y0, y1), pack2(y2, y3));
  }
}

struct ALplain {
  const u16* A; int lda;
  DEV const u16* ptr(int row, int k) const { return A + (size_t)row * lda + k; }
};
struct ALcmp {
  const u16* pb;
  DEV const u16* ptr(int row, int k) const {
    int tok = 16 * row + (k >> 6); tok = tok > (T_ - 1) ? (T_ - 1) : tok;
    return pb + (size_t)tok * PW_ + (k & 63);
  }
};

template <class AL, class EPI>
DEV void gemm_tile(unsigned char* smem, const AL& al, const u16* __restrict__ Bt, int ldb, int nk, const EPI& epi, int m0, int n0) {
  const int tid = opaque_tid(), lane = tid & 63, wave = tid >> 6;
  const int wm = wave >> 1, wn = wave & 1;
  const int r = lane & 31, h = lane >> 5;
  unsigned char* lds = smem;
  const int lr = lane >> 3, lp = lane & 7;
  const int sw = (r >> 1) & 7;
  f32x16 acc[2][2];
#pragma unroll
  for (int a = 0; a < 2; ++a)
#pragma unroll
    for (int b = 0; b < 2; ++b)
#pragma unroll
      for (int i = 0; i < 16; ++i) acc[a][b][i] = 0.f;
#define DMA_A(i_, kt_, buf_)                                                             \
  {                                                                                      \
    const int row_ = ((i_) * 4 + wave) * 8 + lr;                                         \
    const int c_ = lp ^ ((row_ >> 1) & 7);                                               \
    __builtin_amdgcn_global_load_lds((const unsigned*)al.ptr(m0 + row_, (kt_) * 64 + c_ * 8),                                  \
                                     (unsigned*)(lds + (buf_) * 32768 + ((i_) * 4 + wave) * 1024 + lane * 16), 16, 0, 0);      \
  }
#define DMA_B(i_, kt_, buf_)                                                             \
  {                                                                                      \
    const int row_ = ((i_) * 4 + wave) * 8 + lr;                                         \
    const int c_ = lp ^ ((row_ >> 1) & 7);                                               \
    __builtin_amdgcn_global_load_lds((const unsigned*)(Bt + (size_t)(n0 + row_) * ldb + (kt_) * 64 + c_ * 8),                  \
                                     (unsigned*)(lds + (buf_) * 32768 + 16384 + ((i_) * 4 + wave) * 1024 + lane * 16), 16, 0, 0); \
  }
#define MMA4(buf_, ks_)                                                                  \
  {                                                                                      \
    bf16x8 a[2], b[2];                                                                   \
    const int p_ = ((2 * (ks_) + h) ^ sw) * 16;                                          \
    _Pragma("unroll") for (int mt = 0; mt < 2; ++mt) a[mt] = *(const bf16x8*)(lds + (buf_) * 32768 + (wm * 64 + mt * 32 + r) * 128 + p_);          \
    _Pragma("unroll") for (int nt = 0; nt < 2; ++nt) b[nt] = *(const bf16x8*)(lds + (buf_) * 32768 + 16384 + (wn * 64 + nt * 32 + r) * 128 + p_);  \
    _Pragma("unroll") for (int mt = 0; mt < 2; ++mt)                                     \
      _Pragma("unroll") for (int nt = 0; nt < 2; ++nt) acc[mt][nt] = __builtin_amdgcn_mfma_f32_32x32x16_bf16(a[mt], b[nt], acc[mt][nt], 0, 0, 0); \
  }
#define DMA_WAIT_BARRIER()                                                               \
  {                                                                                      \
    asm volatile("s_waitcnt vmcnt(0)" ::: "memory");                                     \
    __builtin_amdgcn_s_barrier();                                                        \
    asm volatile("" ::: "memory");                                                       \
  }
  DMA_A(0, 0, 0); DMA_A(1, 0, 0); DMA_A(2, 0, 0); DMA_A(3, 0, 0);
  DMA_B(0, 0, 0); DMA_B(1, 0, 0); DMA_B(2, 0, 0); DMA_B(3, 0, 0);
  DMA_WAIT_BARRIER();
  for (int kt = 0; kt < nk - 1; ++kt) {
    const int buf = kt & 1, nbuf = buf ^ 1;
    DMA_A(0, kt + 1, nbuf); DMA_A(1, kt + 1, nbuf); DMA_B(0, kt + 1, nbuf); DMA_B(1, kt + 1, nbuf);
    MMA4(buf, 0);
    DMA_A(2, kt + 1, nbuf); DMA_A(3, kt + 1, nbuf); DMA_B(2, kt + 1, nbuf); DMA_B(3, kt + 1, nbuf);
    MMA4(buf, 1);
    MMA4(buf, 2);
    MMA4(buf, 3);
    DMA_WAIT_BARRIER();
  }
  typename EPI::State est;
  epi.pre(est, m0 + wm * 64, n0 + wn * 64, r, h);
  __builtin_amdgcn_sched_barrier(0);
  MMA4(1, 0);
  MMA4(1, 1);
  MMA4(1, 2);
  MMA4(1, 3);
  DMA_WAIT_BARRIER();
#undef DMA_A
#undef DMA_B
#undef MMA4
#undef DMA_WAIT_BARRIER
  epi(acc, est, m0 + wm * 64, n0 + wn * 64, r, h);
}

struct EpiUp {
  u16* act;
  struct State {};
  DEV void pre(State&, int, int, int, int) const {}
  DEV void operator()(f32x16 (&acc)[2][2], State&, int mb, int nb, int r, int h) const {
    const int col = (nb >> 1) + r;
#pragma unroll
    for (int mt = 0; mt < 2; ++mt)
#pragma unroll
      for (int i = 0; i < 16; ++i) {
        const int m = mb + mt * 32 + (i & 3) + 8 * (i >> 2) + 4 * h;
        const float g = acc[mt][0][i], u = acc[mt][1][i];
        act[(size_t)m * DFF_ + col] = f2bf(g / (1.f + __expf(-g)) * u);
      }
  }
};
struct EpiRes {
  const float* src; float* dst; const float* gate; float coef;
  struct State { float sv[2][2][16]; float gg[2]; };
  DEV void pre(State& st, int mb, int nb, int r, int h) const {
#pragma unroll
    for (int nt = 0; nt < 2; ++nt) st.gg[nt] = gate[(mb >> 13) * 9216 + nb + nt * 32 + r] * coef;
#pragma unroll
    for (int mt = 0; mt < 2; ++mt)
#pragma unroll
      for (int nt = 0; nt < 2; ++nt)
#pragma unroll
        for (int i = 0; i < 16; ++i) {
          const int m = mb + mt * 32 + (i & 3) + 8 * (i >> 2) + 4 * h;
          st.sv[mt][nt][i] = src[(size_t)m * 1024 + nb + nt * 32 + r];
        }
  }
  DEV void operator()(f32x16 (&acc)[2][2], State& st, int mb, int nb, int r, int h) const {
#pragma unroll
    for (int mt = 0; mt < 2; ++mt)
#pragma unroll
      for (int nt = 0; nt < 2; ++nt)
#pragma unroll
        for (int i = 0; i < 16; ++i) {
          const int m = mb + mt * 32 + (i & 3) + 8 * (i >> 2) + 4 * h;
          dst[(size_t)m * 1024 + nb + nt * 32 + r] = st.sv[mt][nt][i] + st.gg[nt] * acc[mt][nt][i];
        }
  }
};
struct EpiIn {
  u16* proj; float* side;
  struct State {};
  DEV void pre(State&, int, int, int, int) const {}
  DEV void operator()(f32x16 (&acc)[2][2], State&, int mb, int nb, int r, int h) const {
#pragma unroll
    for (int mt = 0; mt < 2; ++mt)
#pragma unroll
      for (int nt = 0; nt < 2; ++nt) {
        const int n = nb + nt * 32 + r;
        int sidx = -1;
        if (n >= 1024 && n < 1032) sidx = n - 1024;
        else if (n >= 2056 && n < 2064) sidx = 8 + n - 2056;
        else if (n >= 3344 && n < 3368) sidx = 16 + n - 3344;
#pragma unroll
        for (int i = 0; i < 16; ++i) {
          const int m = mb + mt * 32 + (i & 3) + 8 * (i >> 2) + 4 * h;
          proj[(size_t)m * PW_ + n] = f2bf(acc[mt][nt][i]);
          if (sidx >= 0) side[(size_t)m * 40 + sidx] = acc[mt][nt][i];
        }
      }
  }
};
struct EpiHid {
  u16* hid; const float* bias;
  struct State {};
  DEV void pre(State&, int, int, int, int) const {}
  DEV void operator()(f32x16 (&acc)[2][2], State&, int mb, int nb, int r, int h) const {
#pragma unroll
    for (int mt = 0; mt < 2; ++mt)
#pragma unroll
      for (int nt = 0; nt < 2; ++nt) {
        const int n = nb + nt * 32 + r;
        const float bb = bias[n];
#pragma unroll
        for (int i = 0; i < 16; ++i) {
          const int m = mb + mt * 32 + (i & 3) + 8 * (i >> 2) + 4 * h;
          hid[(size_t)m * 256 + n] = f2bf(siluf_(acc[mt][nt][i] + bb));
        }
      }
  }
};

template <bool TA, bool TB>
DEV void mm64(const float* A, const float* B, float (&acc)[4][4], int ti, int tj) {
#pragma unroll 4
  for (int k = 0; k < 64; ++k) {
    float a[4], b[4];
#pragma unroll
    for (int ii = 0; ii < 4; ++ii) a[ii] = TA ? A[k * 65 + ti + 16 * ii] : A[(ti + 16 * ii) * 65 + k];
#pragma unroll
    for (int jj = 0; jj < 4; ++jj) b[jj] = TB ? B[(tj + 16 * jj) * 65 + k] : B[k * 65 + tj + 16 * jj];
#pragma unroll
    for (int ii = 0; ii < 4; ++ii)
#pragma unroll
      for (int jj = 0; jj < 4; ++jj) acc[ii][jj] += a[ii] * b[jj];
  }
}
#define ZERO44(a_) { _Pragma("unroll") for (int ii = 0; ii < 4; ++ii) _Pragma("unroll") for (int jj = 0; jj < 4; ++jj) a_[ii][jj] = 0.f; }

template <bool TA, bool TB>
DEV void mm64m(const float* A, const float* B, f32x16& acc, int i0, int j0, int lane) {
  const int r = lane & 31, kh = lane >> 5;
#pragma unroll 8
  for (int k = 0; k < 64; k += 2) {
    const float a = TA ? A[(k + kh) * 65 + i0 + r] : A[(i0 + r) * 65 + k + kh];
    const float b = TB ? B[(j0 + r) * 65 + k + kh] : B[(k + kh) * 65 + j0 + r];
    acc = __builtin_amdgcn_mfma_f32_32x32x2f32(a, b, acc, 0, 0, 0);
  }
}
#define ZERO16(a_) { _Pragma("unroll") for (int q = 0; q < 16; ++q) a_[q] = 0.f; }
#define QROW(q_) (rb + ((q_) & 3) + 8 * ((q_) >> 2))

DEV void load_blk(const u16* __restrict__ src, float* dst, float scale) {
  const int tid = opaque_tid(), r = tid >> 2, seg = tid & 3;
  const uint4* s = (const uint4*)(src + (size_t)r * PW_ + seg * 16);
  uint4 a = s[0], b = s[1];
  uint32_t w[8] = {a.x, a.y, a.z, a.w, b.x, b.y, b.z, b.w};
#pragma unroll
  for (int i = 0; i < 8; ++i) {
    dst[r * 65 + seg * 16 + 2 * i] = bflo(w[i]) * scale;
    dst[r * 65 + seg * 16 + 2 * i + 1] = bfhi(w[i]) * scale;
  }
}

DEV void job_ml_prep(const Params& p, int l, int job, float* sm) {
  const int tid = opaque_tid(), lane = tid & 63, wave = tid >> 6;
  const int i0 = (wave >> 1) * 32, j0 = (wave & 1) * 32, rb = i0 + 4 * (lane >> 5), cc = j0 + (lane & 31);
  const int c = job & 127, bh = job >> 7, b = bh >> 2, h = bh & 3;
  const int t0 = c * 64;
  const u16* proj = (const u16*)(p.ws + OFF_PROJ);
  const float* side = (const float*)(p.ws + OFF_SIDE);
  float* Qs = sm, *Ks = sm + 4160, *Vs = sm + 8320, *Ss = sm + 12480;
  float* vec = sm + 16640;
  float* li = vec, *lf = vec + 64, *cum = vec + 128, *dmx = vec + 192, *wgt = vec + 256, *misc = vec + 320;
  const size_t tokb = (size_t)b * T_ + t0;
  load_blk(proj + tokb * PW_ + 0 + h * 64, Qs, 0.125f);
  load_blk(proj + tokb * PW_ + 256 + h * 64, Ks, 1.f);
  load_blk(proj + tokb * PW_ + 512 + h * 64, Vs, 1.f);
  if (tid < 64) {
    const float* sd = side + (tokb + tid) * 40;
    const float* gb = p.in[9] + l * 8;
    li[tid] = sd[h] + gb[h];
    const float xf = sd[4 + h] + gb[4 + h];
    lf[tid] = fminf(xf, 0.f) - log1pf(expf(-fabsf(xf)));
  }
  if (tid < 64) {
    const float run = wave_scan_add(lf[tid], tid);
    const float pm = wave_scan_max(li[tid] - run, tid);
    cum[tid] = run; dmx[tid] = run + pm;
    if (tid == 63) misc[1] = run;
  }
  __syncthreads();
  const float gtot = misc[1];
  if (tid < 64) {
    const float a = gtot - cum[tid] + li[tid];
    const float ml = wave_max(a);
    wgt[tid] = expf(a - ml);
    if (tid == 0) misc[0] = ml;
  }
  f32x16 acc;
  ZERO16(acc);
  mm64m<false, true>(Qs, Ks, acc, i0, j0, lane);
#pragma unroll
  for (int q = 0; q < 16; ++q) {
    const int t = QROW(q), j = cc;
    Ss[t * 65 + j] = (j <= t) ? acc[q] * expf(cum[t] - cum[j] + li[j] - dmx[t]) : 0.f;
  }
  __syncthreads();
  float* sv = (float*)(p.ws + OFF_MLSV) + (size_t)job * 4096;
  float* kv = (float*)(p.ws + OFF_MLKV) + (size_t)job * 4096;
  float* vo = (float*)(p.ws + OFF_MLVEC) + (size_t)job * 320;
  ZERO16(acc);
  mm64m<false, false>(Ss, Vs, acc, i0, j0, lane);
#pragma unroll
  for (int q = 0; q < 16; ++q) sv[QROW(q) * 64 + cc] = acc[q];
  if (tid < 64) {
    float s = 0.f;
    for (int j = 0; j < 64; ++j) s += Ss[tid * 65 + j];
    vo[0 * 64 + tid] = s; vo[1 * 64 + tid] = dmx[tid]; vo[2 * 64 + tid] = cum[tid];
    if (tid == 0) { vo[4 * 64 + 0] = misc[0]; vo[4 * 64 + 1] = gtot; }
  }
  for (int idx = tid; idx < 4096; idx += 256) { const int j = idx >> 6, d = idx & 63; Ks[j * 65 + d] *= wgt[j]; }
  __syncthreads();
  ZERO16(acc);
  mm64m<true, false>(Ks, Vs, acc, i0, j0, lane);
#pragma unroll
  for (int q = 0; q < 16; ++q) kv[QROW(q) * 64 + cc] = acc[q];
  if (tid < 64) {
    float s = 0.f;
    for (int j = 0; j < 64; ++j) s += Ks[j * 65 + tid];
    vo[3 * 64 + tid] = s;
  }
  __syncthreads();
}

DEV void job_ml_scan(const Params& p, int job) {
  __builtin_amdgcn_s_setprio(3);
  const int tid = opaque_tid();
  const int bh = job / 17, part = job % 17;
  const float* __restrict__ kvb = (const float*)(p.ws + OFF_MLKV) + (size_t)bh * 128 * 4096;
  float* __restrict__ cpb = (float*)(p.ws + OFF_CPREV) + (size_t)bh * 128 * 4096;
  float* __restrict__ npb = (float*)(p.ws + OFF_NPREV) + (size_t)bh * 128 * 64;
  float* vob = (float*)(p.ws + OFF_MLVEC) + (size_t)bh * 128 * 320;
  float m = 0.f, C = 0.f;
  const int idx = part * 256 + tid;
#pragma unroll 8
  for (int c = 0; c < 128; ++c) {
    float* vo = vob + c * 320;
    const float gt = vo[4 * 64 + 1], ml = vo[4 * 64 + 0];
    const float mn = fmaxf(gt + m, ml);
    const float so = expf(gt + m - mn), sn = expf(ml - mn);
    if (part < 16) {
      const float kvv = kvb[(size_t)c * 4096 + idx];
      cpb[(size_t)c * 4096 + idx] = C;
      C = so * C + sn * kvv;
    } else {
      if (tid < 64) { const float nl = vo[3 * 64 + tid]; npb[c * 64 + tid] = C; C = so * C + sn * nl; }
      else if (tid == 64) vo[4 * 64 + 2] = m;
    }
    m = mn;
  }
  __builtin_amdgcn_s_setprio(0);
}

DEV void job_ml_out(const Params& p, int l, int job, float* sm) {
  const int tid = opaque_tid(), ti = tid >> 4, tj = tid & 15;
  const int c = job & 127, bh = job >> 7, b = bh >> 2, h = bh & 3;
  const int t0 = c * 64;
  const u16* proj = (const u16*)(p.ws + OFF_PROJ);
  u16* y = (u16*)(p.ws + OFF_HB);
  float* Qs = sm, *Cs = sm + 4160;
  float* vec = sm + 16640;
  float* rr = vec, *it = vec + 64;
  const size_t tokb = (size_t)b * T_ + t0;
  const float* sv = (const float*)(p.ws + OFF_MLSV) + (size_t)job * 4096;
  const float* cp = (const float*)(p.ws + OFF_CPREV) + (size_t)job * 4096;
  const float* npv = (const float*)(p.ws + OFF_NPREV) + (size_t)job * 64;
  const float* vo = (const float*)(p.ws + OFF_MLVEC) + (size_t)job * 320;
  load_blk(proj + tokb * PW_ + 0 + h * 64, Qs, 0.125f);
  for (int idx = tid; idx < 4096; idx += 256) Cs[(idx >> 6) * 65 + (idx & 63)] = cp[idx];
  const float* nw = p.in[10] + l * 64;
  float svv[4][4], ogv[4][4], nwv[4];
#pragma unroll
  for (int jj = 0; jj < 4; ++jj) nwv[jj] = nw[tj + 16 * jj];
#pragma unroll
  for (int ii = 0; ii < 4; ++ii)
#pragma unroll
    for (int jj = 0; jj < 4; ++jj) {
      const int t = ti + 16 * ii, e = tj + 16 * jj;
      svv[ii][jj] = sv[t * 64 + e];
      ogv[ii][jj] = bf2f(proj[(tokb + t) * PW_ + 768 + h * 64 + e]);
    }
  __builtin_amdgcn_sched_barrier(0);
  __syncthreads();
  if (tid < 64) {
    float qn = 0.f;
    for (int d = 0; d < 64; ++d) qn += Qs[tid * 65 + d] * npv[d];
    const float mprev = vo[4 * 64 + 2];
    const float cumt = vo[2 * 64 + tid], dmax = vo[1 * 64 + tid], ssum = vo[0 * 64 + tid];
    const float minter = cumt + mprev;
    const float mt = fmaxf(minter, dmax);
    const float r = expf(dmax - mt), inter = expf(minter - mt);
    float den = r * ssum + inter * qn;
    den = fmaxf(fabsf(den), expf(-mt));
    rr[tid] = r / den; it[tid] = inter / den;
  }
  float acc[4][4];
  {
    const int lane_ = tid & 63, wave_ = tid >> 6;
    const int i0 = (wave_ >> 1) * 32, j0 = (wave_ & 1) * 32, rb = i0 + 4 * (lane_ >> 5), cc = j0 + (lane_ & 31);
    float* Hs = sm + 8320;
    f32x16 am;
    ZERO16(am);
    mm64m<false, false>(Qs, Cs, am, i0, j0, lane_);
#pragma unroll
    for (int q = 0; q < 16; ++q) Hs[QROW(q) * 65 + cc] = am[q];
    __syncthreads();
#pragma unroll
    for (int ii = 0; ii < 4; ++ii)
#pragma unroll
      for (int jj = 0; jj < 4; ++jj) acc[ii][jj] = Hs[(ti + 16 * ii) * 65 + tj + 16 * jj];
  }
#pragma unroll
  for (int ii = 0; ii < 4; ++ii) {
    const int t = ti + 16 * ii;
    float hv[4]; float ss = 0.f;
#pragma unroll
    for (int jj = 0; jj < 4; ++jj) { hv[jj] = rr[t] * svv[ii][jj] + it[t] * acc[ii][jj]; ss += hv[jj] * hv[jj]; }
    ss = row16_sum(ss);
    const float rs = rsqrtf(ss * (1.f / 64.f) + 1e-6f);
#pragma unroll
    for (int jj = 0; jj < 4; ++jj) {
      const int e = tj + 16 * jj;
      y[(tokb + t) * 1024 + h * 64 + e] = f2bf(sigmoidf_(ogv[ii][jj]) * hv[jj] * rs * nwv[jj]);
    }
  }
  __syncthreads();
}

DEV void gdn_load_conv(const u16* __restrict__ proj, const float* __restrict__ cw, int b, int t0, int h, int which, float* dst, float post, bool l2n) {
  const int tid = opaque_tid(), r = tid >> 2, seg = tid & 3;
  const int ch0 = which * 256 + h * 64 + seg * 16;
  float a[16];
#pragma unroll
  for (int e = 0; e < 16; ++e) a[e] = 0.f;
#pragma unroll
  for (int kk = 0; kk < 4; ++kk) {
    const int tt = t0 + r - 3 + kk;
    if (tt >= 0) {
      const uint4* s = (const uint4*)(proj + ((size_t)b * T_ + tt) * PW_ + 1032 + ch0);
      uint4 u0 = s[0], u1 = s[1];
      uint32_t w[8] = {u0.x, u0.y, u0.z, u0.w, u1.x, u1.y, u1.z, u1.w};
      const float* cwk = cw + kk * 768 + ch0;
#pragma unroll
      for (int i = 0; i < 8; ++i) { a[2 * i] += cwk[2 * i] * bflo(w[i]); a[2 * i + 1] += cwk[2 * i + 1] * bfhi(w[i]); }
    }
  }
  float ss = 0.f;
#pragma unroll
  for (int e = 0; e < 16; ++e) { a[e] = siluf_(a[e]); ss += a[e] * a[e]; }
  float sc = post;
  if (l2n) { ss += __shfl_xor(ss, 1); ss += __shfl_xor(ss, 2); sc = rsqrtf(ss + 1e-6f) * post; }
#pragma unroll
  for (int e = 0; e < 16; ++e) dst[r * 65 + seg * 16 + e] = a[e] * sc;
}

DEV void job_gdn_prep(const Params& p, int l, int job, float* sm) {
  const int tid = opaque_tid(), lane = tid & 63, wave = tid >> 6;
  const int i0 = (wave >> 1) * 32, j0 = (wave & 1) * 32, rb = i0 + 4 * (lane >> 5), cc = j0 + (lane & 31);
  const int c = job & 127, bh = job >> 7, b = bh >> 2, h = bh & 3;
  const int t0 = c * 64;
  const u16* proj = (const u16*)(p.ws + OFF_PROJ);
  const float* side = (const float*)(p.ws + OFF_SIDE);
  const float* cw = p.in[11] + l * 4 * 768;
  float* B1 = sm, *B2 = sm + 4160, *B3 = sm + 8320, *B4 = sm + 12480;
  float* vec = sm + 16640;
  float* bet = vec, *gam = vec + 64, *eg = vec + 128;
  gdn_load_conv(proj, cw, b, t0, h, 1, B1, 1.f, true);
  gdn_load_conv(proj, cw, b, t0, h, 2, B2, 1.f, false);
  if (tid < 64) {
    const float* sd = side + ((size_t)b * T_ + t0 + tid) * 40;
    bet[tid] = sigmoidf_(sd[12 + h]);
    const float x = sd[8 + h] + p.in[13][l * 4 + h];
    const float sp = x > 20.f ? x : log1pf(expf(x));
    const float g = wave_scan_add(-expf(p.in[12][l * 4 + h]) * sp, tid);
    gam[tid] = g; eg[tid] = expf(g);
  }
  __syncthreads();
  f32x16 acc;
  ZERO16(acc);
  mm64m<false, true>(B1, B1, acc, i0, j0, lane);
#pragma unroll
  for (int q = 0; q < 16; ++q) {
    const int t = QROW(q), j = cc;
    B3[t * 65 + j] = (t > j) ? bet[t] * acc[q] * expf(gam[t] - gam[j]) : 0.f;
  }
  __syncthreads();
  if (tid < 128) {
    const bool isU = tid < 64; const int cc = tid & 63;
    float* X = isU ? B2 : B4;
    if (isU) { for (int t = 0; t < 64; ++t) X[t * 65 + cc] *= bet[t]; }
    else { for (int t = 0; t < 64; ++t) X[t * 65 + cc] = bet[t] * eg[t] * B1[t * 65 + cc]; }
    for (int tb = 0; tb < 64; tb += 8) {
      float rr[8];
#pragma unroll
      for (int u = 0; u < 8; ++u) rr[u] = X[(tb + u) * 65 + cc];
#pragma unroll 4
      for (int j = 0; j < tb; ++j) {
        const float xj = X[j * 65 + cc];
#pragma unroll
        for (int u = 0; u < 8; ++u) rr[u] -= B3[(tb + u) * 65 + j] * xj;
      }
#pragma unroll
      for (int u = 1; u < 8; ++u)
#pragma unroll
        for (int v = 0; v < u; ++v) rr[u] -= B3[(tb + u) * 65 + tb + v] * rr[v];
#pragma unroll
      for (int u = 0; u < 8; ++u) X[(tb + u) * 65 + cc] = rr[u];
    }
  }
  __syncthreads();
  gdn_load_conv(proj, cw, b, t0, h, 0, B3, 0.125f, true);
  __syncthreads();
  f32x16 P;
  ZERO16(P);
  mm64m<false, true>(B3, B1, P, i0, j0, lane);
#pragma unroll
  for (int q = 0; q < 16; ++q) {
    const int t = QROW(q), j = cc;
    P[q] = (t >= j) ? P[q] * expf(gam[t] - gam[j]) : 0.f;
  }
  __syncthreads();
  const float g63 = gam[63];
  for (int idx = tid; idx < 4096; idx += 256) { const int ll = idx >> 6, d = idx & 63; B1[ll * 65 + d] *= expf(g63 - gam[ll]); }
  __syncthreads();
  const float gl = eg[63];
  float* Mo = (float*)(p.ws + OFF_GDM) + (size_t)job * 4096;
  float* Bo = (float*)(p.ws + OFF_GDB) + (size_t)job * 4096;
  float* Qo = (float*)(p.ws + OFF_GDQ) + (size_t)job * 4096;
  float* Po = (float*)(p.ws + OFF_GDP) + (size_t)job * 4096;
  ZERO16(acc);
  mm64m<true, false>(B1, B4, acc, i0, j0, lane);
#pragma unroll
  for (int q = 0; q < 16; ++q) { const int d = QROW(q), d2 = cc; Mo[d * 64 + d2] = (d == d2 ? gl : 0.f) - acc[q]; }
  ZERO16(acc);
  mm64m<true, false>(B1, B2, acc, i0, j0, lane);
#pragma unroll
  for (int q = 0; q < 16; ++q) Bo[QROW(q) * 64 + cc] = acc[q];
  __syncthreads();
#pragma unroll
  for (int q = 0; q < 16; ++q) B1[QROW(q) * 65 + cc] = P[q];
  __syncthreads();
  ZERO16(acc);
  mm64m<false, false>(B1, B4, acc, i0, j0, lane);
#pragma unroll
  for (int q = 0; q < 16; ++q) { const int t = QROW(q), d = cc; Qo[t * 64 + d] = B3[t * 65 + d] * eg[t] - acc[q]; }
  ZERO16(acc);
  mm64m<false, false>(B1, B2, acc, i0, j0, lane);
#pragma unroll
  for (int q = 0; q < 16; ++q) Po[QROW(q) * 64 + cc] = acc[q];
  __syncthreads();
}

DEV void job_gdn_scan(const Params& p, int job, float* sm) {
  __builtin_amdgcn_s_setprio(3);
  const int tid = opaque_tid(), d = tid >> 2, e = tid & 3;
  const int bh = job >> 4, slice = job & 15, col = slice * 4 + e;
  const float* Mb = (const float*)(p.ws + OFF_GDM) + (size_t)bh * 128 * 4096;
  const float* Bb = (const float*)(p.ws + OFF_GDB) + (size_t)bh * 128 * 4096 + d * 64 + col;
  float* Sb = (float*)(p.ws + OFF_SPREV) + (size_t)bh * 128 * 4096 + d * 64 + col;
  float* Ml = sm;
  float* Sl = sm + 8704;
  const int lrow = tid >> 4, lc4 = (tid & 15) * 4;
  float S = 0.f;
  float4 a0, a1, a2, a3, b0, b1, b2, b3;
  float bvA, bvB;
#define LOADM(c_, A, B, C, D) { const float4* mp = (const float4*)(Mb + (size_t)(c_) * 4096); A = mp[tid]; B = mp[tid + 256]; C = mp[tid + 512]; D = mp[tid + 768]; }
#define STOREM(st_, A, B, C, D) { float* ml = Ml + (st_) * 4352 + lrow * 68 + lc4; *(float4*)ml = A; *(float4*)(ml + 16 * 68) = B; *(float4*)(ml + 32 * 68) = C; *(float4*)(ml + 48 * 68) = D; }
#define GSTEP(c_, A, B, C, D, BV)                                                        \
  {                                                                                      \
    float* sl = Sl + ((c_) & 1) * 272;                                                   \
    sl[e * 68 + d] = S;                                                                  \
    const float bcur = BV;                                                               \
    Sb[(size_t)(c_) * 4096] = S;                                                         \
    __syncthreads();                                                                     \
    if ((c_) + 1 < 128) STOREM(((c_) + 1) & 1, A, B, C, D);                              \
    if ((c_) + 3 < 128) LOADM((c_) + 3, A, B, C, D);                                     \
    if ((c_) + 2 < 128) BV = Bb[(size_t)((c_) + 2) * 4096];                              \
    __builtin_amdgcn_sched_barrier(0);                                                   \
    const float* mlc = Ml + ((c_) & 1) * 4352 + d * 68;                                  \
    float acc_ = bcur;                                                                   \
    _Pragma("unroll") for (int i = 0; i < 16; ++i) {                                     \
      const float4 m4 = *(const float4*)(mlc + 4 * i);                                   \
      const float4 s4 = *(const float4*)(sl + e * 68 + 4 * i);                           \
      acc_ += m4.x * s4.x + m4.y * s4.y + m4.z * s4.z + m4.w * s4.w;                     \
    }                                                                                    \
    S = acc_;                                                                            \
  }
  LOADM(0, a0, a1, a2, a3);
  STOREM(0, a0, a1, a2, a3);
  LOADM(1, a0, a1, a2, a3);
  LOADM(2, b0, b1, b2, b3);
  bvA = Bb[0]; bvB = Bb[4096];
  for (int c = 0; c < 128; c += 2) {
    GSTEP(c, a0, a1, a2, a3, bvA);
    GSTEP(c + 1, b0, b1, b2, b3, bvB);
  }
#undef LOADM
#undef STOREM
#undef GSTEP
  __builtin_amdgcn_s_setprio(0);
  __syncthreads();
}

DEV void job_gdn_out(const Params& p, int l, int job, float* sm) {
  const int tid = opaque_tid(), ti = tid >> 4, tj = tid & 15;
  const int c = job & 127, bh = job >> 7, b = bh >> 2, h = bh & 3;
  const int t0 = c * 64;
  const u16* proj = (const u16*)(p.ws + OFF_PROJ);
  u16* y = (u16*)(p.ws + OFF_HB);
  float* B1 = sm, *B2 = sm + 4160;
  const float* Qo = (const float*)(p.ws + OFF_GDQ) + (size_t)job * 4096;
  const float* So = (const float*)(p.ws + OFF_SPREV) + (size_t)job * 4096;
  const float* Po = (const float*)(p.ws + OFF_GDP) + (size_t)job * 4096;
  for (int idx = tid; idx < 4096; idx += 256) { B1[(idx >> 6) * 65 + (idx & 63)] = Qo[idx]; B2[(idx >> 6) * 65 + (idx & 63)] = So[idx]; }
  const float* nw = p.in[14] + l * 64;
  const size_t tokb = (size_t)b * T_ + t0;
  float pov[4][4], zv[4][4], nwv[4];
#pragma unroll
  for (int jj = 0; jj < 4; ++jj) nwv[jj] = nw[tj + 16 * jj];
#pragma unroll
  for (int ii = 0; ii < 4; ++ii)
#pragma unroll
    for (int jj = 0; jj < 4; ++jj) {
      const int t = ti + 16 * ii, e = tj + 16 * jj;
      pov[ii][jj] = Po[t * 64 + e];
      zv[ii][jj] = bf2f(proj[(tokb + t) * PW_ + 1800 + h * 64 + e]);
    }
  __builtin_amdgcn_sched_barrier(0);
  __syncthreads();
  float acc[4][4];
  {
    const int lane_ = tid & 63, wave_ = tid >> 6;
    const int i0 = (wave_ >> 1) * 32, j0 = (wave_ & 1) * 32, rb = i0 + 4 * (lane_ >> 5), cc = j0 + (lane_ & 31);
    float* Hs = sm + 8320;
    f32x16 am;
    ZERO16(am);
    mm64m<false, false>(B1, B2, am, i0, j0, lane_);
#pragma unroll
    for (int q = 0; q < 16; ++q) Hs[QROW(q) * 65 + cc] = am[q];
    __syncthreads();
#pragma unroll
    for (int ii = 0; ii < 4; ++ii)
#pragma unroll
      for (int jj = 0; jj < 4; ++jj) acc[ii][jj] = Hs[(ti + 16 * ii) * 65 + tj + 16 * jj];
  }
#pragma unroll
  for (int ii = 0; ii < 4; ++ii) {
    const int t = ti + 16 * ii;
    float ov[4]; float ss = 0.f;
#pragma unroll
    for (int jj = 0; jj < 4; ++jj) { ov[jj] = acc[ii][jj] + pov[ii][jj]; ss += ov[jj] * ov[jj]; }
    ss = row16_sum(ss);
    const float rs = rsqrtf(ss * (1.f / 64.f) + 1e-6f);
#pragma unroll
    for (int jj = 0; jj < 4; ++jj) {
      const int e = tj + 16 * jj;
      y[(tokb + t) * 1024 + 256 + h * 64 + e] = f2bf(ov[jj] * rs * nwv[jj] * siluf_(zv[ii][jj]));
    }
  }
  __syncthreads();
}

DEV void job_nsa_tok(const Params& p, int l, int job) {
  const int tid = opaque_tid(), lane = tid & 63, wave = tid >> 6;
  const int tok = job * 4 + wave, b = tok >> 13, t = tok & 8191;
  const u16* proj = (const u16*)(p.ws + OFF_PROJ);
  u16* qn = (u16*)(p.ws + OFF_QN);
  u16* ks = (u16*)(p.ws + OFF_KS);
  u16* kw = (u16*)(p.ws + OFF_KW);
  const float* qkn = p.in[15] + l * 256;
  const int i = lane & 31;
  const float inv = exp2f(-(float)i * (13.287712379549449f / 32.f));
  const float ang = (float)t * inv;
  const float sn = sinf(ang), cs = cosf(ang);
  float xv[12];
#pragma unroll
  for (int v = 0; v < 12; ++v) {
    const int col = v < 8 ? 2064 + v * 64 : (v < 10 ? 2064 + 512 + 2 * 128 + (v - 8) * 64 : 2064 + 512 + 4 * 128 + (v - 10) * 64);
    xv[v] = bf2f(proj[(size_t)tok * PW_ + col + lane]);
  }
#pragma unroll
  for (int v = 0; v < 12; ++v) {
    int wsel; u16* dst; float post = 1.f;
    if (v < 8) { wsel = 0; dst = qn + (((size_t)(b * 8 + v)) * T_ + t) * 64; post = 0.125f * 1.4426950408889634f; }
    else if (v < 10) { wsel = 2; dst = ks + (((size_t)(b * 2 + v - 8)) * T_ + t) * 64; }
    else { wsel = 3; dst = kw + (((size_t)(b * 2 + v - 10)) * T_ + t) * 64; }
    const float x = xv[v];
    const float ss = wave_sum(x * x);
    const float yv = x * rsqrtf(ss * (1.f / 64.f) + 1e-6f) * qkn[wsel * 64 + lane];
    const float o = __shfl_xor(yv, 32);
    const float out = lane < 32 ? yv * cs - o * sn : o * sn + yv * cs;
    dst[lane] = f2bf(out * post);
  }
}

DEV void job_nsa_vt(const Params& p, int job, unsigned char* smem) {
  const int tid = opaque_tid();
  const int tile = job & 127, bh = (job >> 7) & 3, which = job >> 9;
  const int b = bh >> 1, hkv = bh & 1, t0 = tile * 64;
  const u16* proj = (const u16*)(p.ws + OFF_PROJ);
  u16* vt = (u16*)(p.ws + (which == 0 ? OFF_VST : OFF_VWT));
  const int col = 2064 + 512 + (which == 0 ? 3 : 5) * 128 + hkv * 64;
  u16* sm = (u16*)smem;
  {
    const int rr = tid >> 2, seg = tid & 3;
    const uint4* s = (const uint4*)(proj + ((size_t)b * T_ + t0 + rr) * PW_ + col + seg * 16);
    uint4 a = s[0], bq = s[1];
    uint32_t* d = (uint32_t*)(sm + rr * 66 + seg * 16);
    d[0] = a.x; d[1] = a.y; d[2] = a.z; d[3] = a.w; d[4] = bq.x; d[5] = bq.y; d[6] = bq.z; d[7] = bq.w;
  }
  __syncthreads();
  {
    const int d = tid >> 2, seg = tid & 3;
    uint32_t w[8];
#pragma unroll
    for (int i = 0; i < 8; ++i) w[i] = (uint32_t)sm[(seg * 16 + 2 * i) * 66 + d] | ((uint32_t)sm[(seg * 16 + 2 * i + 1) * 66 + d] << 16);
    uint4* o = (uint4*)(vt + ((size_t)(b * 2 + hkv) * 64 + d) * T_ + t0 + seg * 16);
    o[0] = make_uint4(w[0], w[1], w[2], w[3]);
    o[1] = make_uint4(w[4], w[5], w[6], w[7]);
  }
  __syncthreads();
}

DEV void job_cmp2(const Params& p, int l, int job, float* sm) {
  const int tid = opaque_tid(), lane = tid & 63, wave = tid >> 6;
  const int wjob = job * 4 + wave, prob = wjob >> 9, n = wjob & 511;
  const int b = prob >> 2, hkv = (prob >> 1) & 1, kv = prob & 1;
  const u16* hid = (const u16*)(p.ws + OFF_HID) + ((size_t)prob * 512 + n) * 256;
  float* hrow = sm + wave * 256;
  {
    const uint2 hv = *(const uint2*)(hid + lane * 4);
    hrow[lane * 4 + 0] = bflo(hv.x); hrow[lane * 4 + 1] = bfhi(hv.x);
    hrow[lane * 4 + 2] = bflo(hv.y); hrow[lane * 4 + 3] = bfhi(hv.y);
  }
  __syncthreads();
  const float* w2 = p.in[18] + ((size_t)(l * 2 + kv)) * 256 * 64;
  float o = 0.f;
#pragma unroll 32
  for (int j = 0; j < 256; ++j) o += hrow[j] * w2[j * 64 + lane];
  if (n == 511) o = 0.f;
  if (kv == 0) {
    const float ss = wave_sum(o * o);
    const float yv = o * rsqrtf(ss * (1.f / 64.f) + 1e-6f) * p.in[15][l * 256 + 64 + lane];
    const int i = lane & 31;
    const float inv = exp2f(-(float)i * (13.287712379549449f / 32.f));
    const float ang = (float)(16 * n + 31) * inv;
    const float sn = sinf(ang), cs = cosf(ang);
    const float ot = __shfl_xor(yv, 32);
    float out = lane < 32 ? yv * cs - ot * sn : ot * sn + yv * cs;
    if (n == 511) out = 0.f;
    ((u16*)(p.ws + OFF_KC))[((size_t)(b * 2 + hkv) * 512 + n) * 64 + lane] = f2bf(out);
  } else {
    ((u16*)(p.ws + OFF_VCT))[((size_t)(b * 2 + hkv) * 64 + lane) * 512 + n] = f2bf(o);
  }
  __syncthreads();
}

template <int MODE, bool IMP>
DEV void nsa_loop(u16* Ks, u16* Vs, const u16* __restrict__ kb, const u16* __restrict__ vb, int vstride,
                  int ntile, int tile_lo, const int* tlist, const bf16x8 (&qf)[4], int t, int t0, int c, int h,
                  float& m, float& lsum, f32x16 (&acc)[2], uint32_t sw0, uint32_t sw1, uint32_t sw2, uint32_t sw3,
                  float* imp, int tl, float inv_l) {
  const int tid = opaque_tid();
  uint4 rk0, rk1, rv0, rv1;
  const int lrow0 = tid >> 3, lpart = tid & 7, lrow1 = lrow0 + 32;
#define TILEID(idx_) (MODE == 1 ? tlist[idx_] : tile_lo + (idx_))
#define NGLOAD(tix_)                                                                     \
  {                                                                                      \
    const int key0_ = (tix_) * 64;                                                       \
    rk0 = *(const uint4*)(kb + (size_t)(key0_ + lrow0) * 64 + lpart * 8);                \
    rk1 = *(const uint4*)(kb + (size_t)(key0_ + lrow1) * 64 + lpart * 8);                \
    if (!IMP) {                                                                          \
      rv0 = *(const uint4*)(vb + (size_t)lrow0 * vstride + key0_ + lpart * 8);           \
      rv1 = *(const uint4*)(vb + (size_t)lrow1 * vstride + key0_ + lpart * 8);           \
    }                                                                                    \
  }
#define NSSTORE(buf_)                                                                    \
  {                                                                                      \
    *(uint4*)(Ks + ((buf_) * 64 + lrow0) * 72 + lpart * 8) = rk0;                        \
    *(uint4*)(Ks + ((buf_) * 64 + lrow1) * 72 + lpart * 8) = rk1;                        \
    if (!IMP) {                                                                          \
      *(uint4*)(Vs + ((buf_) * 64 + lrow0) * 72 + lpart * 8) = rv0;                      \
      *(uint4*)(Vs + ((buf_) * 64 + lrow1) * 72 + lpart * 8) = rv1;                      \
    }                                                                                    \
  }
  NGLOAD(TILEID(0));
  NSSTORE(0);
  __syncthreads();
  for (int idx = 0; idx < ntile; ++idx) {
    const int buf = idx & 1;
    const int tix = TILEID(idx);
    const int key0 = tix * 64;
    if (idx + 1 < ntile) NGLOAD(TILEID(idx + 1));
    __builtin_amdgcn_sched_barrier(0);
    bool tv = true;
    if (MODE == 1) {
      const int w = tix >> 5;
      const uint32_t sw = w == 0 ? sw0 : (w == 1 ? sw1 : (w == 2 ? sw2 : sw3));
      tv = (sw >> (tix & 31)) & 1u;
    }
    const bool wave_any = (MODE != 1) || (__builtin_amdgcn_ballot_w64(tv) != 0ull);
    if (wave_any) {
    f32x16 s[2];
#pragma unroll
    for (int kt = 0; kt < 2; ++kt) {
#pragma unroll
      for (int i = 0; i < 16; ++i) s[kt][i] = 0.f;
#pragma unroll
      for (int ks = 0; ks < 4; ++ks) {
        const bf16x8 a = *(const bf16x8*)(Ks + (buf * 64 + kt * 32 + c) * 72 + ks * 16 + 8 * h);
        s[kt] = __builtin_amdgcn_mfma_f32_32x32x16_bf16(a, qf[ks], s[kt], 0, 0, 0);
      }
    }
    bool need_mask;
    if (MODE == 0) need_mask = !(16 * (key0 + 63) + 31 <= t0);
    else if (MODE == 1) need_mask = (key0 + 63 > t0);
    else need_mask = !((key0 + 63 <= t0) && (key0 + 512 > t0 + 31));
    if (IMP) need_mask = true;
    float mx = -1e30f;
    if (need_mask) {
#pragma unroll
      for (int kt = 0; kt < 2; ++kt)
#pragma unroll
        for (int i = 0; i < 16; ++i) {
          const int key = key0 + kt * 32 + (i & 3) + 8 * (i >> 2) + 4 * h;
          bool v;
          if (MODE == 0) v = (16 * key + 31 <= t);
          else if (MODE == 1) v = tv && (key <= t);
          else v = (key <= t) && (key + 512 > t);
          const float sv = v ? s[kt][i] : -1e30f;
          s[kt][i] = sv;
          mx = fmaxf(mx, sv);
        }
    } else {
#pragma unroll
      for (int kt = 0; kt < 2; ++kt)
#pragma unroll
        for (int i = 0; i < 16; ++i) mx = fmaxf(mx, s[kt][i]);
      if (MODE == 1 && !tv) mx = -1e30f;
    }
    if (!IMP) {
      mx = fmaxf(mx, __shfl_xor(mx, 32));
      const bool grew = __builtin_amdgcn_ballot_w64(mx > m + 8.0f) != 0ull;
      float mn = m, alpha = 1.f;
      if (grew) { mn = fmaxf(m, mx); alpha = __builtin_amdgcn_exp2f(m - mn); m = mn; }
      float ps = 0.f;
      if (need_mask) {
#pragma unroll
        for (int kt = 0; kt < 2; ++kt)
#pragma unroll
          for (int i = 0; i < 16; ++i) {
            const float pv = s[kt][i] > -1e29f ? __builtin_amdgcn_exp2f(s[kt][i] - mn) : 0.f;
            s[kt][i] = pv; ps += pv;
          }
      } else {
        const float msub = (MODE == 1 && !tv) ? 1e30f : mn;
#pragma unroll
        for (int kt = 0; kt < 2; ++kt)
#pragma unroll
          for (int i = 0; i < 16; ++i) {
            const float pv = __builtin_amdgcn_exp2f(s[kt][i] - msub);
            s[kt][i] = pv; ps += pv;
          }
      }
      lsum = lsum * alpha + ps;
      if (grew) {
#pragma unroll
        for (int i = 0; i < 16; ++i) { acc[0][i] *= alpha; acc[1][i] *= alpha; }
      }
#pragma unroll
      for (int kt = 0; kt < 2; ++kt)
#pragma unroll
        for (int s2 = 0; s2 < 2; ++s2) {
          union { u32x4 u; bf16x8 v; } pf;
          pf.u[0] = cvtpk(s[kt][8 * s2 + 0], s[kt][8 * s2 + 1]);
          pf.u[1] = cvtpk(s[kt][8 * s2 + 2], s[kt][8 * s2 + 3]);
          pf.u[2] = cvtpk(s[kt][8 * s2 + 4], s[kt][8 * s2 + 5]);
          pf.u[3] = cvtpk(s[kt][8 * s2 + 6], s[kt][8 * s2 + 7]);
#pragma unroll
          for (int dt = 0; dt < 2; ++dt) {
            const u16* vp = Vs + (buf * 64 + dt * 32 + c) * 72 + kt * 32 + 16 * s2 + 4 * h;
            const uint2 lo = *(const uint2*)vp;
            const uint2 hi = *(const uint2*)(vp + 8);
            union { u32x4 u; bf16x8 v; } af;
            af.u[0] = lo.x; af.u[1] = lo.y; af.u[2] = hi.x; af.u[3] = hi.y;
            acc[dt] = __builtin_amdgcn_mfma_f32_32x32x16_bf16(af.v, pf.v, acc[dt], 0, 0, 0);
          }
        }
    } else {
#pragma unroll
      for (int kt = 0; kt < 2; ++kt)
#pragma unroll
        for (int q4 = 0; q4 < 4; ++q4) {
          float pr[4];
#pragma unroll
          for (int e = 0; e < 4; ++e) {
            const float sv = s[kt][4 * q4 + e];
            pr[e] = sv > -1e29f ? __builtin_amdgcn_exp2f(sv - m) * inv_l : 0.f;
          }
          float a = pr[0] + pr[1] + pr[2] + 0.5f * pr[3];
          float bq = 0.5f * pr[3];
          a += dpp_f(a, 0); a += dpp_f(a, 1);
          bq += dpp_f(bq, 0); bq += dpp_f(bq, 1);
          if ((c & 3) == 0) {
            const int mi = (key0 + kt * 32 + 8 * q4 + 4 * h) >> 2;
            atomicAdd(&imp[tl * 129 + mi], a);
            if (mi + 1 < 128) atomicAdd(&imp[tl * 129 + mi + 1], bq);
          }
        }
    }
    }
    if (idx + 1 < ntile) NSSTORE(buf ^ 1);
    __syncthreads();
  }
#undef TILEID
#undef NGLOAD
#undef NSSTORE
}

template <bool FIRST>
DEV void nsa_emit(u16* y, f32x16 (&acc)[2], int h) {
#pragma unroll
  for (int dt = 0; dt < 2; ++dt)
#pragma unroll
    for (int i4 = 0; i4 < 4; ++i4) {
      const int d = dt * 32 + 8 * i4 + 4 * h;
      float v0 = acc[dt][4 * i4 + 0], v1 = acc[dt][4 * i4 + 1], v2 = acc[dt][4 * i4 + 2], v3 = acc[dt][4 * i4 + 3];
      if (!FIRST) {
        const uint2 o = *(const uint2*)(y + d);
        v0 += bflo(o.x); v1 += bfhi(o.x); v2 += bflo(o.y); v3 += bfhi(o.y);
      }
      *(uint2*)(y + d) = make_uint2(pack2(v0, v1), pack2(v2, v3));
    }
#pragma unroll
  for (int i = 0; i < 16; ++i) { acc[0][i] = 0.f; acc[1][i] = 0.f; }
}

DEV void job_nsa_attn(const Params& p, int l, int job, unsigned char* smem) {
  __builtin_amdgcn_s_setprio(2);
  const int tid = opaque_tid(), lane = tid & 63, wave = tid >> 6;
  const int c = lane & 31, h = lane >> 5;
  const int tile = 255 - (job >> 2), bh = job & 3, b = bh >> 1, hkv = bh & 1;
  const int t0 = tile * 32, cur = t0 >> 6;
  const int tl = wave * 8 + (c >> 2), g = c & 3, head = hkv * 4 + g;
  const int t = t0 + tl;
  const size_t tok = (size_t)b * T_ + t;
  u16* Ks = (u16*)smem;
  u16* Vs = Ks + 2 * 64 * 72;
  float* imp = (float*)(smem + 36864);
  uint32_t* selm = (uint32_t*)(smem + 36864 + 16512);
  int* tlist = (int*)(smem + 36864 + 16512 + 512);
  int* misc = tlist + 128;
  uint32_t* unim = (uint32_t*)(misc + 4);
  const u16* qn = (const u16*)(p.ws + OFF_QN);
  const u16* qptr = qn + (((size_t)(b * 8 + head)) * T_ + t) * 64;
  bf16x8 qf[4];
#pragma unroll
  for (int ks = 0; ks < 4; ++ks) qf[ks] = *(const bf16x8*)(qptr + ks * 16 + 8 * h);
  const float* sd = (const float*)(p.ws + OFF_SIDE) + tok * 40 + 16;
  const float g0 = sigmoidf_(sd[head]), g1 = sigmoidf_(sd[8 + head]), g2 = sigmoidf_(sd[16 + head]);
  f32x16 acc[2];
#pragma unroll
  for (int i = 0; i < 16; ++i) { acc[0][i] = 0.f; acc[1][i] = 0.f; }
  u16* y = (u16*)(p.ws + OFF_HB) + tok * 1024 + 512 + head * 64;
  const int bk = b * 2 + hkv;
  const u16* kc = (const u16*)(p.ws + OFF_KC) + (size_t)bk * 512 * 64;
  const u16* vct = (const u16*)(p.ws + OFF_VCT) + (size_t)bk * 64 * 512;
  const int ncmp = (t0 >> 10) + 1;
  float m = -1e30f, ls = 0.f;
  nsa_loop<0, false>(Ks, Vs, kc, vct, 512, ncmp, 0, tlist, qf, t, t0, c, h, m, ls, acc, 0u, 0u, 0u, 0u, imp, tl, 0.f);
  {
    const float lt = ls + __shfl_xor(ls, 32);
    const float inv = lt > 0.f ? 1.f / lt : 0.f;
    const float f = g0 * inv;
#pragma unroll
    for (int i = 0; i < 16; ++i) { acc[0][i] *= f; acc[1][i] *= f; }
    nsa_emit<true>(y, acc, h);
    int ntl;
    if (cur >= 16) {
      for (int idx = tid; idx < 32 * 129; idx += 256) imp[idx] = 0.f;
      if (tid < 128) selm[tid] = 0u;
      __syncthreads();
      float dm = 0.f;
      nsa_loop<0, true>(Ks, Vs, kc, vct, 512, ncmp, 0, tlist, qf, t, t0, c, h, m, dm, acc, 0u, 0u, 0u, 0u, imp, tl, inv);
      {
        const int hiC = cur - 2;
        float v1[8], v2[8];
        uint32_t mk[8][4];
#pragma unroll
        for (int q = 0; q < 8; ++q) {
          const float* row = imp + (wave * 8 + q) * 129;
          v1[q] = (lane >= 1 && lane <= hiC) ? row[lane] : -1.f;
          v2[q] = (lane + 64 <= hiC) ? row[lane + 64] : -1.f;
          mk[q][0] = 1u; mk[q][1] = 0u; mk[q][2] = 0u; mk[q][3] = 0u;
        }
        for (int rnd = 0; rnd < 13; ++rnd) {
          float wm[8];
#pragma unroll
          for (int q = 0; q < 8; ++q) wm[q] = fmaxf(v1[q], v2[q]);
#pragma unroll
          for (int q = 0; q < 8; ++q) wm[q] = wave_max_valu(wm[q]);
#pragma unroll
          for (int q = 0; q < 8; ++q) {
            const unsigned long long bl1 = __builtin_amdgcn_ballot_w64(v1[q] == wm[q]);
            const unsigned long long bl2 = __builtin_amdgcn_ballot_w64(v2[q] == wm[q]);
            int selj;
            if (bl1 != 0ull) { const int ow = __builtin_ctzll(bl1); if (lane == ow) v1[q] = -1.f; selj = ow; }
            else { const int ow = __builtin_ctzll(bl2); if (lane == ow) v2[q] = -1.f; selj = ow + 64; }
            const uint32_t bit = 1u << (selj & 31);
            const int wsel = selj >> 5;
            mk[q][0] |= wsel == 0 ? bit : 0u; mk[q][1] |= wsel == 1 ? bit : 0u;
            mk[q][2] |= wsel == 2 ? bit : 0u; mk[q][3] |= wsel == 3 ? bit : 0u;
          }
        }
        if (lane == 0) {
#pragma unroll
          for (int q = 0; q < 8; ++q) {
            uint32_t f0 = mk[q][0], f1 = mk[q][1], f2 = mk[q][2], f3 = mk[q][3];
#pragma unroll
            for (int z = 0; z < 2; ++z) {
              const int jf = cur - z; const uint32_t bit = 1u << (jf & 31); const int wsel = jf >> 5;
              f0 |= wsel == 0 ? bit : 0u; f1 |= wsel == 1 ? bit : 0u; f2 |= wsel == 2 ? bit : 0u; f3 |= wsel == 3 ? bit : 0u;
            }
            uint32_t* sp = selm + (wave * 8 + q) * 4;
            sp[0] = f0; sp[1] = f1; sp[2] = f2; sp[3] = f3;
          }
        }
      }
      __syncthreads();
      if (tid < 4) unim[tid] = 0u;
      __syncthreads();
      if (tid < 128) atomicOr(&unim[tid & 3], selm[tid]);
      __syncthreads();
      if (tid < 128) {
        const uint32_t u0 = unim[0], u1 = unim[1], u2 = unim[2], u3 = unim[3];
        const int j = tid, w = j >> 5;
        const uint32_t uw = w == 0 ? u0 : (w == 1 ? u1 : (w == 2 ? u2 : u3));
        const int below = (w > 0 ? __popc(u0) : 0) + (w > 1 ? __popc(u1) : 0) + (w > 2 ? __popc(u2) : 0) + __popc(uw & ((1u << (j & 31)) - 1u));
        if (j <= cur && ((uw >> (j & 31)) & 1u)) tlist[below] = j;
        if (j == 0) misc[0] = __popc(u0) + __popc(u1) + __popc(u2) + __popc(u3);
      }
      __syncthreads();
      ntl = misc[0];
    } else {
      if (tid < 128) { tlist[tid] = tid; selm[tid] = 0xffffffffu; }
      __syncthreads();
      ntl = cur + 1;
    }
    const uint32_t sw0 = selm[tl * 4 + 0], sw1 = selm[tl * 4 + 1], sw2 = selm[tl * 4 + 2], sw3 = selm[tl * 4 + 3];
    const u16* ksb = (const u16*)(p.ws + OFF_KS) + (size_t)bk * T_ * 64;
    const u16* vsb = (const u16*)(p.ws + OFF_VST) + (size_t)bk * 64 * T_;
    m = -1e30f; ls = 0.f;
    nsa_loop<1, false>(Ks, Vs, ksb, vsb, T_, ntl, 0, tlist, qf, t, t0, c, h, m, ls, acc, sw0, sw1, sw2, sw3, imp, tl, 0.f);
    {
      const float lt2 = ls + __shfl_xor(ls, 32);
      const float f2 = g1 / lt2;
#pragma unroll
      for (int i = 0; i < 16; ++i) { acc[0][i] *= f2; acc[1][i] *= f2; }
      nsa_emit<false>(y, acc, h);
    }
  }
  {
    const u16* kwb = (const u16*)(p.ws + OFF_KW) + (size_t)bk * T_ * 64;
    const u16* vwb = (const u16*)(p.ws + OFF_VWT) + (size_t)bk * 64 * T_;
    const int lo = (t0 - 511 > 0 ? t0 - 511 : 0) >> 6;
    m = -1e30f; ls = 0.f;
    nsa_loop<2, false>(Ks, Vs, kwb, vwb, T_, cur - lo + 1, lo, tlist, qf, t, t0, c, h, m, ls, acc, 0u, 0u, 0u, 0u, imp, tl, 0.f);
    const float lt3 = ls + __shfl_xor(ls, 32);
    const float f3 = g2 / lt3;
#pragma unroll
    for (int i = 0; i < 16; ++i) { acc[0][i] *= f3; acc[1][i] *= f3; }
    nsa_emit<false>(y, acc, h);
  }
  __builtin_amdgcn_s_setprio(0);
  __syncthreads();
}

#define XB_TMO      128
#define XB_XCNT(j)  (256  + 64 * (j))
#define XB_XSUB(j)  (1280 + 64 * (j))
#define XB_XGEN(j)  (2304 + 64 * (j))
#define XB_TOP      3328
#define XB_TOPGEN   3392
#define XCD_BAR_WORDS 3456
#define XB_RANKW(j) (3456 + 64 * (j))
#define XB_ALL_WORDS (3456 + 64 * 16 + 64 * 6)
#define XB_QUEUE(k) (3456 + 64 * 16 + 64 * (k))
#define XB_SPIN_CAP (1u << 18)
#define LAS __attribute__((address_space(3)))
DEV unsigned xb_ld(unsigned* p)              { return __hip_atomic_load(p, __ATOMIC_RELAXED, __HIP_MEMORY_SCOPE_AGENT); }
DEV unsigned xb_add(unsigned* p, unsigned v) { return __hip_atomic_fetch_add(p, v, __ATOMIC_RELAXED, __HIP_MEMORY_SCOPE_AGENT); }
DEV unsigned xb_xcc_id() { return (unsigned)__builtin_amdgcn_s_getreg((3 << 11) | 20) & 0xFu; }
#define XB_SPIN(cond, bar) do { unsigned _sp = 0; while (cond) { __builtin_amdgcn_s_sleep(1); \
    if ((++_sp & 255u) == 0u) { if (xb_ld(&(bar)[XB_TMO])) break; if (_sp > XB_SPIN_CAP) { atomicAdd(&(bar)[XB_TMO], 1u); break; } } } } while (0)
struct XcdBarrier { unsigned* bar; unsigned x; volatile LAS unsigned* st; };
DEV XcdBarrier xcd_barrier_post(unsigned* bar, volatile LAS unsigned* st) {
  XcdBarrier b; b.bar = bar; b.x = xb_xcc_id(); b.st = st;
  if (threadIdx.x == 0) (void)xb_add(&bar[XB_XCNT(b.x)], 1u);
  return b;
}
DEV void xcd_barrier_complete(unsigned* bar, unsigned x, unsigned& nloc, unsigned& nx) {
  const unsigned G = gridDim.x * gridDim.y * gridDim.z;
  unsigned sum, cnt, mine, sp = 0u;
  for (;;) {
    sum = 0u; cnt = 0u; mine = 0u;
#pragma unroll
    for (unsigned j = 0; j < 16; ++j) { const unsigned c = xb_ld(&bar[XB_XCNT(j)]); sum += c; cnt += (c > 0u) ? 1u : 0u; mine = (j == x) ? c : mine; }
    if (sum == G) break;
    __builtin_amdgcn_s_sleep(1);
    if ((++sp & 255u) == 0u) { if (xb_ld(&bar[XB_TMO])) break; if (sp > XB_SPIN_CAP) { atomicAdd(&bar[XB_TMO], 1u); break; } }
  }
  nloc = mine > 0u ? mine : 1u; nx = cnt > 0u ? cnt : 1u;
}
DEV void xcd_barrier(const XcdBarrier& b) {
  asm volatile("s_waitcnt vmcnt(0)" ::: "memory");
  __syncthreads();
  if (threadIdx.x == 0) {
    unsigned* bar = b.bar;
    __builtin_amdgcn_s_waitcnt(0);
    unsigned nloc = b.st[0], nx = b.st[1];
    if (nloc == 0u) { xcd_barrier_complete(bar, b.x, nloc, nx); b.st[0] = nloc; b.st[1] = nx; }
    const unsigned old = xb_add(&bar[XB_XSUB(b.x)], 1u);
    const unsigned gen = old / nloc;
    if (old + 1u == (gen + 1u) * nloc) {
      __builtin_amdgcn_fence(__ATOMIC_RELEASE, "agent");
      asm volatile("s_waitcnt vmcnt(0)" ::: "memory");
      const unsigned og = xb_add(&bar[XB_TOP], 1u);
      const unsigned tg = og / nx;
      if (og + 1u == (tg + 1u) * nx) xb_add(&bar[XB_TOPGEN], 1u);
      else XB_SPIN(xb_ld(&bar[XB_TOPGEN]) == tg, bar);
      __builtin_amdgcn_fence(__ATOMIC_ACQUIRE, "agent");
      xb_add(&bar[XB_XGEN(b.x)], 1u);
      asm volatile("s_waitcnt vmcnt(0)" ::: "memory");
    } else {
      XB_SPIN(xb_ld(&bar[XB_XGEN(b.x)]) == gen, bar);
      __builtin_amdgcn_fence(__ATOMIC_ACQUIRE, "agent");
      asm volatile("s_waitcnt vmcnt(0)" ::: "memory");
    }
  }
  __syncthreads();
}

DEV void wt_ffn_job(const Params& p, int l, int f, int j, float* smf) {
  u16* wt = (u16*)(p.ws + (f == 0 ? OFF_WT : OFF_WTC));
  if (j < 1408) {
    const int rt = j >> 4, ktile = j & 15;
    job_wt(p.in[5] + (size_t)(l * 2 + f) * 1024 * 5632, 5632, wt + WT_UP / 2, 1024, ktile * 64, rt * 64, 1, 0, smf);
  } else {
    const int jj = j - 1408, rt = jj / 44, ktile = jj % 44;
    job_wt(p.in[6] + (size_t)(l * 2 + f) * 2816 * 1024, 1024, wt + WT_DOWN / 2, 2816, ktile * 64, rt * 64, 0, 1024, smf);
  }
}
DEV void wt_mix_job(const Params& p, int l, int j, float* smf) {
  u16* wt = (u16*)(p.ws + OFF_WTB);
  if (j < 864) {
    const int rt = j >> 4, ktile = j & 15;
    job_wt(p.in[7] + (size_t)l * 1024 * INW_, INW_, wt + WT_IN / 2, 1024, ktile * 64, rt * 64, 0, INW_, smf);
  } else if (j < 864 + 256) {
    const int jj = j - 864, rt = jj >> 4, ktile = jj & 15;
    job_wt(p.in[8] + (size_t)l * 1024 * 1024, 1024, wt + WT_OUT / 2, 1024, ktile * 64, rt * 64, 0, 1024, smf);
  } else {
    const int jj = j - 1120, kv = jj >> 7, q = jj & 127, rt = q >> 5, ktile = q & 31;
    job_wt(p.in[17] + (size_t)(l * 2 + kv) * 2048 * 256, 256, wt + WT_W1 / 2 + (size_t)kv * 256 * 2048, 2048, ktile * 64, rt * 64, 0, 256, smf);
  }
}

#define GEMM_TILE_LOOP(NT_, BODY)                                                         \
  {                                                                                       \
    if (bid >= (nb >> 1)) __builtin_amdgcn_s_sleep(13);     \
    const int sn4_ = ((NT_) + 3) >> 2;                                                    \
    const int totS_ = 16 * sn4_;                                                          \
    const int nloc_ = (int)xb.st[0], nx_ = (int)xb.st[1], rank_ = (int)xb.st[2], x_ = (int)xb.x; \
    if (nx_ == 8 && x_ < 8 && (totS_ & 7) == 0 && nloc_ > 0) {                            \
      const int cnt_ = totS_ >> 3, s0_ = x_ * cnt_;                                       \
      for (int o_ = rank_; o_ < cnt_ * 32; o_ += nloc_) {                                 \
        const int S_ = s0_ + (o_ >> 5), w_ = o_ & 31;                                     \
        const int mt_ = (S_ / sn4_) * 8 + (w_ >> 2), nt_ = (S_ % sn4_) * 4 + (w_ & 3);    \
        if (nt_ < (NT_)) { BODY; }                                                        \
      }                                                                                   \
    } else {                                                                              \
      for (int j_ = bid; j_ < 128 * (NT_); j_ += nb) { const int mt_ = j_ / (NT_), nt_ = j_ % (NT_); BODY; } \
    }                                                                                     \
  }

#define DYN_LOOP(QI_, NJOBS_, ...)                                                       \
  for (;;) {                                                                             \
    if (threadIdx.x == 0) xb.st[3] = atomicAdd(&barw[XB_QUEUE(QI_)], 1u);                \
    __syncthreads();                                                                     \
    const int j = (int)xb.st[3];                                                         \
    __syncthreads();                                                                     \
    if (j >= (NJOBS_)) break;                                                            \
    __VA_ARGS__                                                                          \
  }

__global__ void __launch_bounds__(256, 2) fwd_megakernel(Params p) {
  extern __shared__ __attribute__((aligned(16))) unsigned char smem[];
  float* smf = (float*)smem;
  cg::grid_group grid = cg::this_grid();
  const int nb = gridDim.x, bid = blockIdx.x;
  float* mod = (float*)(p.ws + OFF_MOD);
  u16* hb = (u16*)(p.ws + OFF_HB);
  u16* wtb = (u16*)(p.ws + OFF_WTB);
  u16* act = (u16*)(p.ws + OFF_ACT);
  u16* proj = (u16*)(p.ws + OFF_PROJ);
  float* side = (float*)(p.ws + OFF_SIDE);

  unsigned* barw = (unsigned*)(p.ws + OFF_BAR);
  if (bid == nb - 1) { for (int i = threadIdx.x; i < XB_ALL_WORDS; i += 256) barw[i] = 0u; }
  if (threadIdx.x == 0) { ((volatile unsigned*)(smem + LDS_BYTES - 16))[0] = 0u; ((volatile unsigned*)(smem + LDS_BYTES - 16))[1] = 0u; }
  for (int j = bid; j < 288 + 16; j += nb) { if (j < 288) job_mod(p, j, smf); else job_bias1(p, j - 288, smf); }
  {
    const int nconv = 2112 + 1376;
    if (nb > 304 && bid >= 304) {
      const int nw_ = nb - 304, share = (nconv * 5 / 6) / nw_;
      for (int k = 0; k < share; ++k) { const int cj = (bid - 304) + nw_ * k; if (cj < 2112) wt_ffn_job(p, 0, 0, cj, smf); else wt_mix_job(p, 0, cj - 2112, smf); }
      for (int cj = nw_ * share + bid; cj < nconv; cj += nb) { if (cj < 2112) wt_ffn_job(p, 0, 0, cj, smf); else wt_mix_job(p, 0, cj - 2112, smf); }
    } else {
      const int nw_ = nb > 304 ? nb - 304 : 0, share = nw_ > 0 ? (nconv * 5 / 6) / nw_ : 0;
      for (int cj = nw_ * share + bid; cj < nconv; cj += nb) { if (cj < 2112) wt_ffn_job(p, 0, 0, cj, smf); else wt_mix_job(p, 0, cj - 2112, smf); }
    }
  }
  grid.sync();
  const XcdBarrier xb = xcd_barrier_post(barw, (volatile LAS unsigned*)(smem + LDS_BYTES - 16));
  if (threadIdx.x == 0) xb.st[2] = xb_add(&barw[XB_RANKW(xb.x)], 1u);
#define GSYNC() xcd_barrier(xb)

  for (int l = 0; l < 2; ++l) {
    const float* modl = mod + l * 2 * 9216;
    const float* nwl = p.in[4] + l * 3 * 1024;
    for (int f = 0; f < 2; ++f) {
      if (f == 1) {
        for (int j = bid; j < 4096; j += nb) job_adaln(p.out, nwl + 1024, modl, 1, hb, j);
        GSYNC();
        {
          ALplain al{hb, 1024};
          EpiIn epi{proj, side};
          GEMM_TILE_LOOP(27, gemm_tile(smem, al, wtb + WT_IN / 2, 1024, 16, epi, mt_ * 128, nt_ * 128));
        }
        GSYNC();
        DYN_LOOP(l * 2 + 0, 64 + 1024 + 1024 + 640, {
          if (j >= 2112) {
            for (int jl = 2112 + (j - 2112) * 8, je = jl + 8; jl < je; ++jl) {
              if (jl < 6208) job_nsa_tok(p, l, jl - 2112);
              else job_nsa_vt(p, jl - 6208, smem);
            }
          } else
          if (j >= 64 && j < 1088) { SK_GDNPREP(job_gdn_prep(p, l, j - 64, smf);) }
          else if (j < 64) {
            const int q = j, prob = q >> 3, mt = (q >> 1) & 3, nt = q & 1;
            const int b = prob >> 2, hkv = (prob >> 1) & 1, kv = prob & 1;
            ALcmp al{proj + (size_t)b * T_ * PW_ + 2576 + kv * 128 + hkv * 64};
            EpiHid epi{(u16*)(p.ws + OFF_HID) + (size_t)prob * 512 * 256, (const float*)(p.ws + OFF_B1) + (l * 2 + kv) * 256};
            gemm_tile(smem, al, wtb + WT_W1 / 2 + (size_t)kv * 256 * 2048, 2048, 32, epi, mt * 128, nt * 128);
          }
          else if (j < 2112) { SK_MLPREP(job_ml_prep(p, l, j - 1088, smf);) }
        })
        GSYNC();
        DYN_LOOP(4 + l, 128 + 136 + 1024 + 2112 + (l == 0 ? 2112 : 0), {
          if (j < 128) { SK_GDNSCAN(job_gdn_scan(p, j, smf);) }
          else if (j < 264) job_ml_scan(p, j - 128);
          else if (j < 1288) job_cmp2(p, l, j - 264, smf);
          else if (j < 3400) wt_ffn_job(p, l, 1, j - 1288, smf);
          else wt_ffn_job(p, 1, 0, j - 3400, smf);
        })
        GSYNC();
        DYN_LOOP(l * 2 + 1, 3072, {
          if (j < 1024) { SK_NSA(job_nsa_attn(p, l, j, smem);) }
          else if (j < 2048) { SK_MLOUT(job_ml_out(p, l, j - 1024, smf);) }
          else { SK_GDNOUT(job_gdn_out(p, l, j - 2048, smf);) }
        })
        GSYNC();
        {
          ALplain al{hb, 1024};
          EpiRes epi{p.out, p.out, modl + 5 * 1024, 1.0f};
          GEMM_TILE_LOOP(8, gemm_tile(smem, al, wtb + WT_OUT / 2, 1024, 16, epi, mt_ * 128, nt_ * 128));
        }
        GSYNC();
      }
      const int sub = f * 2;
      const float* xsrc = (l == 0 && f == 0) ? p.in[0] : p.out;
      for (int j = bid; j < 4096 + ((l == 0 && f == 1) ? 1376 : 0); j += nb) {
        if (j < 4096) job_adaln(xsrc, nwl + sub * 1024, modl, sub, hb, j);
        else wt_mix_job(p, 1, j - 4096, smf);
      }
      GSYNC();
      u16* wt = (u16*)(p.ws + (f == 0 ? OFF_WT : OFF_WTC));
      {
        ALplain al{hb, 1024};
        EpiUp epi{act};
        GEMM_TILE_LOOP(44, gemm_tile(smem, al, wt + WT_UP / 2, 1024, 16, epi, mt_ * 128, nt_ * 128));
      }
      GSYNC();
      {
        ALplain al{act, DFF_};
        EpiRes epi{xsrc, p.out, modl + (3 * sub + 2) * 1024, 0.5f};
        GEMM_TILE_LOOP(8, gemm_tile(smem, al, wt + WT_DOWN / 2, DFF_, 44, epi, mt_ * 128, nt_ * 128));
      }
      GSYNC();
    }
  }
}

extern "C" void kernel_launch(void* const* d_in, const int* in_sizes, int n_in, void* d_out, int out_size, void* d_ws, size_t ws_size, hipStream_t stream) {
  static int grid_blocks = 0;
  if (!grid_blocks) {
    int dev = 0, cus = 0, per_cu = 0;
    hipGetDevice(&dev);
    hipDeviceGetAttribute(&cus, hipDeviceAttributeMultiprocessorCount, dev);
    hipFuncSetAttribute((const void*)fwd_megakernel, hipFuncAttributeMaxDynamicSharedMemorySize, LDS_BYTES);
    hipOccupancyMaxActiveBlocksPerMultiprocessor(&per_cu, (const void*)fwd_megakernel, 256, LDS_BYTES);
    if (per_cu < 1) per_cu = 1;
    if (per_cu > 2) per_cu = 2;
    grid_blocks = cus * per_cu;
    if (ws_size < OFF_END) fprintf(stderr, "kernel_launch: workspace too small: %zu < %zu\n", ws_size, (size_t)OFF_END);
  }
  Params p{};
  for (int i = 0; i < 19; ++i) p.in[i] = (const float*)d_in[i];
  p.out = (float*)d_out;
  p.ws = (unsigned char*)d_ws;
  void* args[] = {&p};
  hipError_t e = hipLaunchCooperativeKernel((const void*)fwd_megakernel, dim3(grid_blocks), dim3(256), args, LDS_BYTES, stream);
  if (e != hipSuccess) fprintf(stderr, "cooperative launch failed: %s (grid %d)\n", hipGetErrorString(e), grid_blocks);
}
```

```cpp
#include <hip/hip_runtime.h>
#include <hip/hip_cooperative_groups.h>
#include <cstdio>
#include <cstdint>
namespace cg = cooperative_groups;

typedef __attribute__((ext_vector_type(8))) short bf16x8;
typedef __attribute__((ext_vector_type(16))) float f32x16;
typedef __attribute__((ext_vector_type(4))) unsigned int u32x4;
typedef unsigned short u16;


#ifndef REP_GEMM
#define REP_GEMM 1
#endif
#ifndef REP_AD
#define REP_AD 1
#endif
#ifndef EXTRA_SYNC
#define EXTRA_SYNC 0
#endif
#ifndef REP_NSA
#define REP_NSA 1
#endif
#ifndef REP_F2
#define REP_F2 1
#endif
#ifndef REP_P0
#define REP_P0 1
#endif
#ifndef REP_F1
#define REP_F1 1
#endif
#ifndef REP_F3
#define REP_F3 1
#endif
#define DEV __device__ __forceinline__

#ifdef NO_GDNPREP
#define SK_GDNPREP(x)
#else
#define SK_GDNPREP(x) x
#endif
#ifdef NO_MLPREP
#define SK_MLPREP(x)
#else
#define SK_MLPREP(x) x
#endif
#ifdef NO_GDNSCAN
#define SK_GDNSCAN(x)
#else
#define SK_GDNSCAN(x) x
#endif
#ifdef NO_NSA
#define SK_NSA(x)
#else
#define SK_NSA(x) x
#endif
#ifdef NO_MLOUT
#define SK_MLOUT(x)
#else
#define SK_MLOUT(x) x
#endif
#ifdef NO_GDNOUT
#define SK_GDNOUT(x)
#else
#define SK_GDNOUT(x) x
#endif


static constexpr int T_ = 8192;
static constexpr int NT_ = 16384;
static constexpr int DM_ = 1024;
static constexpr int DFF_ = 2816;
static constexpr int PW_ = 3456;
static constexpr int INW_ = 3368;
static constexpr int LDS_BYTES = 75776;

static constexpr size_t OFF_HB   = 0;
static constexpr size_t OFF_WT   = 33554432;
static constexpr size_t OFF_MOD  = OFF_WT + 17301504;
static constexpr size_t OFF_B1   = OFF_MOD + 147456;
static constexpr size_t OFF_BAR  = OFF_MOD + 163840;
static constexpr size_t OFF_R    = OFF_MOD + 262144;
static constexpr size_t OFF_ACT  = OFF_R;
static constexpr size_t OFF_PROJ = OFF_R;
static constexpr size_t OFF_SIDE = OFF_PROJ + 113246208;
static constexpr size_t OFF_MLSV = OFF_SIDE + 2621440;
static constexpr size_t OFF_MLKV = OFF_MLSV + 16777216;
static constexpr size_t OFF_MLVEC= OFF_MLKV + 16777216;
static constexpr size_t OFF_GDM  = OFF_MLVEC + 1310720;
static constexpr size_t OFF_GDB  = OFF_GDM + 16777216;
static constexpr size_t OFF_GDQ  = OFF_GDB + 16777216;
static constexpr size_t OFF_GDP  = OFF_GDQ + 16777216;
static constexpr size_t OFF_QN   = OFF_GDP + 16777216;
static constexpr size_t OFF_KS   = OFF_QN + 16777216;
static constexpr size_t OFF_KW   = OFF_KS + 4194304;
static constexpr size_t OFF_VST  = OFF_KW + 4194304;
static constexpr size_t OFF_VWT  = OFF_VST + 4194304;
static constexpr size_t OFF_HID  = OFF_VWT + 4194304;
static constexpr size_t OFF_KC   = OFF_HID + 2097152;
static constexpr size_t OFF_VCT  = OFF_KC + 262144;
static constexpr size_t OFF_SPREV= OFF_VCT + 262144;
static constexpr size_t OFF_CPREV= OFF_SPREV + 16777216;
static constexpr size_t OFF_NPREV= OFF_CPREV + 16777216;
static constexpr size_t OFF_WTB  = OFF_NPREV + 262144;
static constexpr size_t OFF_WTC  = OFF_WTB + 11272192;
static constexpr size_t OFF_END  = OFF_WTC + 17301504;

static constexpr size_t WT_UP   = 0;
static constexpr size_t WT_DOWN = 11534336;
static constexpr size_t WT_IN   = 0;
static constexpr size_t WT_OUT  = 7077888;
static constexpr size_t WT_W1   = 7077888 + 2097152;

struct Params {
  const float* in[19];
  float* out;
  unsigned char* ws;
};

DEV u16 f2bf(float f) {
  uint32_t u = __float_as_uint(f);
  u += 0x7fffu + ((u >> 16) & 1u);
  return (u16)(u >> 16);
}
DEV int opaque_tid() { int t = threadIdx.x; asm volatile("" : "+v"(t)); return t; }
DEV float bf2f(u16 h) { return __uint_as_float(((uint32_t)h) << 16); }
DEV uint32_t cvtpk(float lo, float hi) { uint32_t r; asm("v_cvt_pk_bf16_f32 %0, %1, %2" : "=v"(r) : "v"(lo), "v"(hi)); return r; }
DEV uint32_t pack2(float a, float b) { return (uint32_t)f2bf(a) | ((uint32_t)f2bf(b) << 16); }
DEV float bflo(uint32_t w) { return __uint_as_float(w << 16); }
DEV float bfhi(uint32_t w) { return __uint_as_float(w & 0xffff0000u); }
DEV float sigmoidf_(float x) { return 1.f / (1.f + expf(-x)); }
DEV float siluf_(float x) { return x / (1.f + expf(-x)); }
DEV float wave_sum_lds(float v) {
#pragma unroll
  for (int o = 32; o >= 1; o >>= 1) v += __shfl_xor(v, o);
  return v;
}
DEV float wave_scan_add(float v, int lane) {
#pragma unroll
  for (int o = 1; o < 64; o <<= 1) { const float u = __shfl_up(v, o); if (lane >= o) v += u; }
  return v;
}
DEV float wave_scan_max(float v, int lane) {
#pragma unroll
  for (int o = 1; o < 64; o <<= 1) { const float u = __shfl_up(v, o); if (lane >= o) v = fmaxf(v, u); }
  return v;
}
DEV float dpp_f(float v, const int ctrl_sel) {
  const int iv = __float_as_int(v);
  int r;
  if (ctrl_sel == 0) r = __builtin_amdgcn_update_dpp(iv, iv, 0xB1, 0xF, 0xF, false);
  else if (ctrl_sel == 1) r = __builtin_amdgcn_update_dpp(iv, iv, 0x4E, 0xF, 0xF, false);
  else if (ctrl_sel == 2) r = __builtin_amdgcn_update_dpp(iv, iv, 0x124, 0xF, 0xF, false);
  else r = __builtin_amdgcn_update_dpp(iv, iv, 0x128, 0xF, 0xF, false);
  return __int_as_float(r);
}
DEV float wave_max_valu(float v) {
  typedef __attribute__((ext_vector_type(2))) unsigned u32x2_;
  v = fmaxf(v, dpp_f(v, 0));
  v = fmaxf(v, dpp_f(v, 1));
  v = fmaxf(v, dpp_f(v, 2));
  v = fmaxf(v, dpp_f(v, 3));
  const u32x2_ a = __builtin_amdgcn_permlane16_swap(__float_as_uint(v), __float_as_uint(v), false, false);
  v = fmaxf(__uint_as_float(a[0]), __uint_as_float(a[1]));
  const u32x2_ b = __builtin_amdgcn_permlane32_swap(__float_as_uint(v), __float_as_uint(v), false, false);
  return fmaxf(__uint_as_float(b[0]), __uint_as_float(b[1]));
}
DEV float wave_sum(float v) {
  typedef __attribute__((ext_vector_type(2))) unsigned u32x2_;
  v += dpp_f(v, 0);
  v += dpp_f(v, 1);
  v += dpp_f(v, 2);
  v += dpp_f(v, 3);
  const u32x2_ a = __builtin_amdgcn_permlane16_swap(__float_as_uint(v), __float_as_uint(v), false, false);
  v = __uint_as_float(a[0]) + __uint_as_float(a[1]);
  const u32x2_ b = __builtin_amdgcn_permlane32_swap(__float_as_uint(v), __float_as_uint(v), false, false);
  return __uint_as_float(b[0]) + __uint_as_float(b[1]);
}
DEV float row16_sum(float v) {
  v += dpp_f(v, 0);
  v += dpp_f(v, 1);
  v += dpp_f(v, 2);
  v += dpp_f(v, 3);
  return v;
}
DEV float wave_max(float v) {
#pragma unroll
  for (int o = 32; o >= 1; o >>= 1) v = fmaxf(v, __shfl_xor(v, o));
  return v;
}

DEV void job_mod(const Params& p, int job, float* sm) {
  const int tid = opaque_tid();
  float* mod = (float*)(p.ws + OFF_MOD);
  const int l = job / 144, cgp = job % 144;
  const int col = cgp * 64 + (tid & 63), kp = tid >> 6;
  const float* W = p.in[2] + (size_t)l * 1024 * 9216;
  const float* c = p.in[1];
  float a0 = 0.f, a1 = 0.f;
  float* cs = sm + 512;
  for (int i = tid; i < 2048; i += 256) cs[i] = siluf_(c[i]);
  __syncthreads();
#pragma unroll 16
  for (int k = kp * 256; k < kp * 256 + 256; ++k) {
    const float w = W[(size_t)k * 9216 + col];
    a0 += cs[k] * w; a1 += cs[1024 + k] * w;
  }
  sm[tid] = a0; sm[256 + tid] = a1;
  __syncthreads();
  if (tid < 64) {
    float bb = p.in[3][l * 9216 + col];
    mod[(l * 2 + 0) * 9216 + col] = sm[tid] + sm[tid + 64] + sm[tid + 128] + sm[tid + 192] + bb;
    mod[(l * 2 + 1) * 9216 + col] = sm[256 + tid] + sm[256 + tid + 64] + sm[256 + tid + 128] + sm[256 + tid + 192] + bb;
  }
  __syncthreads();
}

DEV void job_bias1(const Params& p, int job, float* sm) {
  const int tid = opaque_tid();
  float* b1 = (float*)(p.ws + OFF_B1);
  const int lk = job >> 2, cgp = job & 3;
  const int col = cgp * 64 + (tid & 63), kp = tid >> 6;
  const float* W = p.in[17] + (size_t)lk * 2048 * 256;
  const float* pos = p.in[16] + (size_t)lk * 2048;
  float a = 0.f;
#pragma unroll 32
  for (int j = kp * 512; j < kp * 512 + 512; ++j) a += pos[j] * W[(size_t)j * 256 + col];
  sm[tid] = a;
  __syncthreads();
  if (tid < 64) b1[lk * 256 + col] = sm[tid] + sm[tid + 64] + sm[tid + 128] + sm[tid + 192];
  __syncthreads();
}

DEV void job_wt(const float* __restrict__ src, int ldsrc, u16* __restrict__ dst, int Kdst, int k0, int r0, int mode, int nvalid, float* sm) {
  const int tid = opaque_tid();
  const int rr = tid & 63, kk0 = tid >> 6;
  int scol; bool ok = true;
  if (mode == 1) {
    const int nb = r0 >> 7, wn = (r0 >> 6) & 1, s = rr >> 5, cc = rr & 31;
    scol = s * 2816 + 64 * nb + 32 * wn + cc;
  } else { scol = r0 + rr; ok = scol < nvalid; if (!ok) scol = 0; }
#pragma unroll
  for (int i = 0; i < 16; ++i) {
    const int kk = kk0 + 4 * i;
    float v = src[(size_t)(k0 + kk) * ldsrc + scol];
    sm[kk * 65 + rr] = ok ? v : 0.f;
  }
  __syncthreads();
  const int r = tid >> 2, kq = tid & 3;
  uint32_t w[8];
#pragma unroll
  for (int i = 0; i < 8; ++i) w[i] = pack2(sm[(kq * 16 + 2 * i) * 65 + r], sm[(kq * 16 + 2 * i + 1) * 65 + r]);
  uint4* d = (uint4*)(dst + (size_t)(r0 + r) * Kdst + k0 + kq * 16);
  d[0] = make_uint4(w[0], w[1], w[2], w[3]);
  d[1] = make_uint4(w[4], w[5], w[6], w[7]);
  __syncthreads();
}

DEV void job_adaln(const float* __restrict__ x, const float* __restrict__ nw, const float* __restrict__ modl, int sub, u16* __restrict__ hb, int job) {
  const int tid = opaque_tid(), lane = tid & 63, wave = tid >> 6;
  const int row = job * 4 + wave;
  const int b = row >> 13;
  const float* shift = modl + b * 9216 + (3 * sub) * 1024;
  const float* scale = shift + 1024;
  const float4* xr = (const float4*)(x + (size_t)row * 1024);
  float4 v[4]; float ss = 0.f;
#pragma unroll
  for (int i = 0; i < 4; ++i) { v[i] = xr[lane + 64 * i]; ss += v[i].x * v[i].x + v[i].y * v[i].y + v[i].z * v[i].z + v[i].w * v[i].w; }
  float4 n4v[4], scv[4], shv[4];
#pragma unroll
  for (int i = 0; i < 4; ++i) {
    const int k = (lane + 64 * i) * 4;
    n4v[i] = *(const float4*)(nw + k); scv[i] = *(const float4*)(scale + k); shv[i] = *(const float4*)(shift + k);
  }
  __builtin_amdgcn_sched_barrier(0);
  ss = wave_sum(ss);
  const float rstd = rsqrtf(ss * (1.f / 1024.f) + 1e-6f);
#pragma unroll
  for (int i = 0; i < 4; ++i) {
    const int k = (lane + 64 * i) * 4;
    const float4 n4 = n4v[i], sc = scv[i], sh = shv[i];
    float y0 = v[i].x * rstd * n4.x * (1.f + sc.x) + sh.x;
    float y1 = v[i].y * rstd * n4.y * (1.f + sc.y) + sh.y;
    float y2 = v[i].z * rstd * n4.z * (1.f + sc.z) + sh.z;
    float y3 = v[i].w * rstd * n4.w * (1.f + sc.w) + sh.w;
    *(uint2*)(hb + (size_t)row * 1024 + k) = make_uint2(pack2(y0, y1), pack2(y2, y3));
  }
}

struct ALplain {
  const u16* A; int lda;
  DEV const u16* ptr(int row, int k) const { return A + (size_t)row * lda + k; }
};
struct ALcmp {
  const u16* pb;
  DEV const u16* ptr(int row, int k) const {
    int tok = 16 * row + (k >> 6); tok = tok > (T_ - 1) ? (T_ - 1) : tok;
    return pb + (size_t)tok * PW_ + (k & 63);
  }
};

template <class AL, class EPI>
DEV void gemm_tile(unsigned char* smem, const AL& al, const u16* __restrict__ Bt, int ldb, int nk, const EPI& epi, int m0, int n0) {
  const int tid = opaque_tid(), lane = tid & 63, wave = tid >> 6;
  const int wm = wave >> 1, wn = wave & 1;
  const int r = lane & 31, h = lane >> 5;
  unsigned char* lds = smem;
  const int lr = lane >> 3, lp = lane & 7;
  const int sw = (r >> 1) & 7;
  f32x16 acc[2][2];
#pragma unroll
  for (int a = 0; a < 2; ++a)
#pragma unroll
    for (int b = 0; b < 2; ++b)
#pragma unroll
      for (int i = 0; i < 16; ++i) acc[a][b][i] = 0.f;
#define DMA_A(i_, kt_, buf_)                                                             \
  {                                                                                      \
    const int row_ = ((i_) * 4 + wave) * 8 + lr;                                         \
    const int c_ = lp ^ ((row_ >> 1) & 7);                                               \
    __builtin_amdgcn_global_load_lds((const unsigned*)al.ptr(m0 + row_, (kt_) * 64 + c_ * 8),                                  \
                                     (unsigned*)(lds + (buf_) * 32768 + ((i_) * 4 + wave) * 1024 + lane * 16), 16, 0, 0);      \
  }
#define DMA_B(i_, kt_, buf_)                                                             \
  {                                                                                      \
    const int row_ = ((i_) * 4 + wave) * 8 + lr;                                         \
    const int c_ = lp ^ ((row_ >> 1) & 7);                                               \
    __builtin_amdgcn_global_load_lds((const unsigned*)(Bt + (size_t)(n0 + row_) * ldb + (kt_) * 64 + c_ * 8),                  \
                                     (unsigned*)(lds + (buf_) * 32768 + 16384 + ((i_) * 4 + wave) * 1024 + lane * 16), 16, 0, 0); \
  }
#define MMA4(buf_, ks_)                                                                  \
  {                                                                                      \
    bf16x8 a[2], b[2];                                                                   \
    const int p_ = ((2 * (ks_) + h) ^ sw) * 16;                                          \
    _Pragma("unroll") for (int mt = 0; mt < 2; ++mt) a[mt] = *(const bf16x8*)(lds + (buf_) * 32768 + (wm * 64 + mt * 32 + r) * 128 + p_);          \
    _Pragma("unroll") for (int nt = 0; nt < 2; ++nt) b[nt] = *(const bf16x8*)(lds + (buf_) * 32768 + 16384 + (wn * 64 + nt * 32 + r) * 128 + p_);  \
    _Pragma("unroll") for (int mt = 0; mt < 2; ++mt)                                     \
      _Pragma("unroll") for (int nt = 0; nt < 2; ++nt) acc[mt][nt] = __builtin_amdgcn_mfma_f32_32x32x16_bf16(a[mt], b[nt], acc[mt][nt], 0, 0, 0); \
  }
#define DMA_WAIT_BARRIER()                                                               \
  {                                                                                      \
    asm volatile("s_waitcnt vmcnt(0)" ::: "memory");                                     \
    __builtin_amdgcn_s_barrier();                                                        \
    asm volatile("" ::: "memory");                                                       \
  }
  DMA_A(0, 0, 0); DMA_A(1, 0, 0); DMA_A(2, 0, 0); DMA_A(3, 0, 0);
  DMA_B(0, 0, 0); DMA_B(1, 0, 0); DMA_B(2, 0, 0); DMA_B(3, 0, 0);
  DMA_WAIT_BARRIER();
  for (int kt = 0; kt < nk - 1; ++kt) {
    const int buf = kt & 1, nbuf = buf ^ 1;
    DMA_A(0, kt + 1, nbuf); DMA_A(1, kt + 1, nbuf); DMA_B(0, kt + 1, nbuf); DMA_B(1, kt + 1, nbuf);
    MMA4(buf, 0);
    DMA_A(2, kt + 1, nbuf); DMA_A(3, kt + 1, nbuf); DMA_B(2, kt + 1, nbuf); DMA_B(3, kt + 1, nbuf);
    MMA4(buf, 1);
    MMA4(buf, 2);
    MMA4(buf, 3);
    DMA_WAIT_BARRIER();
  }
  typename EPI::State est;
  epi.pre(est, m0 + wm * 64, n0 + wn * 64, r, h);
  __builtin_amdgcn_sched_barrier(0);
  MMA4(1, 0);
  MMA4(1, 1);
  MMA4(1, 2);
  MMA4(1, 3);
  DMA_WAIT_BARRIER();
#undef DMA_A
#undef DMA_B
#undef MMA4
#undef DMA_WAIT_BARRIER
  epi(acc, est, m0 + wm * 64, n0 + wn * 64, r, h);
}

struct EpiUp {
  u16* act;
  struct State {};
  DEV void pre(State&, int, int, int, int) const {}
  DEV void operator()(f32x16 (&acc)[2][2], State&, int mb, int nb, int r, int h) const {
    const int col = (nb >> 1) + r;
#pragma unroll
    for (int mt = 0; mt < 2; ++mt)
#pragma unroll
      for (int i = 0; i < 16; ++i) {
        const int m = mb + mt * 32 + (i & 3) + 8 * (i >> 2) + 4 * h;
        const float g = acc[mt][0][i], u = acc[mt][1][i];
        act[(size_t)m * DFF_ + col] = f2bf(g / (1.f + __expf(-g)) * u);
      }
  }
};
struct EpiRes {
  const float* src; float* dst; const float* gate; float coef;
  struct State { float sv[2][2][16]; float gg[2]; };
  DEV void pre(State& st, int mb, int nb, int r, int h) const {
#pragma unroll
    for (int nt = 0; nt < 2; ++nt) st.gg[nt] = gate[(mb >> 13) * 9216 + nb + nt * 32 + r] * coef;
#pragma unroll
    for (int mt = 0; mt < 2; ++mt)
#pragma unroll
      for (int nt = 0; nt < 2; ++nt)
#pragma unroll
        for (int i = 0; i < 16; ++i) {
          const int m = mb + mt * 32 + (i & 3) + 8 * (i >> 2) + 4 * h;
          st.sv[mt][nt][i] = src[(size_t)m * 1024 + nb + nt * 32 + r];
        }
  }
  DEV void operator()(f32x16 (&acc)[2][2], State& st, int mb, int nb, int r, int h) const {
#pragma unroll
    for (int mt = 0; mt < 2; ++mt)
#pragma unroll
      for (int nt = 0; nt < 2; ++nt)
#pragma unroll
        for (int i = 0; i < 16; ++i) {
          const int m = mb + mt * 32 + (i & 3) + 8 * (i >> 2) + 4 * h;
          dst[(size_t)m * 1024 + nb + nt * 32 + r] = st.sv[mt][nt][i] + st.gg[nt] * acc[mt][nt][i];
        }
  }
};
struct EpiIn {
  u16* proj; float* side;
  struct State {};
  DEV void pre(State&, int, int, int, int) const {}
  DEV void operator()(f32x16 (&acc)[2][2], State&, int mb, int nb, int r, int h) const {
#pragma unroll
    for (int mt = 0; mt < 2; ++mt)
#pragma unroll
      for (int nt = 0; nt < 2; ++nt) {
        const int n = nb + nt * 32 + r;
        int sidx = -1;
        if (n >= 1024 && n < 1032) sidx = n - 1024;
        else if (n >= 2056 && n < 2064) sidx = 8 + n - 2056;
        else if (n >= 3344 && n < 3368) sidx = 16 + n - 3344;
#pragma unroll
        for (int i = 0; i < 16; ++i) {
          const int m = mb + mt * 32 + (i & 3) + 8 * (i >> 2) + 4 * h;
          proj[(size_t)m * PW_ + n] = f2bf(acc[mt][nt][i]);
          if (sidx >= 0) side[(size_t)m * 40 + sidx] = acc[mt][nt][i];
        }
      }
  }
};
struct EpiHid {
  u16* hid; const float* bias;
  struct State {};
  DEV void pre(State&, int, int, int, int) const {}
  DEV void operator()(f32x16 (&acc)[2][2], State&, int mb, int nb, int r, int h) const {
#pragma unroll
    for (int mt = 0; mt < 2; ++mt)
#pragma unroll
      for (int nt = 0; nt < 2; ++nt) {
        const int n = nb + nt * 32 + r;
        const float bb = bias[n];
#pragma unroll
        for (int i = 0; i < 16; ++i) {
          const int m = mb + mt * 32 + (i & 3) + 8 * (i >> 2) + 4 * h;
          hid[(size_t)m * 256 + n] = f2bf(siluf_(acc[mt][nt][i] + bb));
        }
      }
  }
};

template <bool TA, bool TB>
DEV void mm64(const float* A, const float* B, float (&acc)[4][4], int ti, int tj) {
#pragma unroll 4
  for (int k = 0; k < 64; ++k) {
    float a[4], b[4];
#pragma unroll
    for (int ii = 0; ii < 4; ++ii) a[ii] = TA ? A[k * 65 + ti + 16 * ii] : A[(ti + 16 * ii) * 65 + k];
#pragma unroll
    for (int jj = 0; jj < 4; ++jj) b[jj] = TB ? B[(tj + 16 * jj) * 65 + k] : B[k * 65 + tj + 16 * jj];
#pragma unroll
    for (int ii = 0; ii < 4; ++ii)
#pragma unroll
      for (int jj = 0; jj < 4; ++jj) acc[ii][jj] += a[ii] * b[jj];
  }
}
#define ZERO44(a_) { _Pragma("unroll") for (int ii = 0; ii < 4; ++ii) _Pragma("unroll") for (int jj = 0; jj < 4; ++jj) a_[ii][jj] = 0.f; }

template <bool TA, bool TB>
DEV void mm64m(const float* A, const float* B, f32x16& acc, int i0, int j0, int lane) {
  const int r = lane & 31, kh = lane >> 5;
#pragma unroll 8
  for (int k = 0; k < 64; k += 2) {
    const float a = TA ? A[(k + kh) * 65 + i0 + r] : A[(i0 + r) * 65 + k + kh];
    const float b = TB ? B[(j0 + r) * 65 + k + kh] : B[(k + kh) * 65 + j0 + r];
    acc = __builtin_amdgcn_mfma_f32_32x32x2f32(a, b, acc, 0, 0, 0);
  }
}
#define ZERO16(a_) { _Pragma("unroll") for (int q = 0; q < 16; ++q) a_[q] = 0.f; }
#define QROW(q_) (rb + ((q_) & 3) + 8 * ((q_) >> 2))

DEV void load_blk(const u16* __restrict__ src, float* dst, float scale) {
  const int tid = opaque_tid(), r = tid >> 2, seg = tid & 3;
  const uint4* s = (const uint4*)(src + (size_t)r * PW_ + seg * 16);
  uint4 a = s[0], b = s[1];
  uint32_t w[8] = {a.x, a.y, a.z, a.w, b.x, b.y, b.z, b.w};
#pragma unroll
  for (int i = 0; i < 8; ++i) {
    dst[r * 65 + seg * 16 + 2 * i] = bflo(w[i]) * scale;
    dst[r * 65 + seg * 16 + 2 * i + 1] = bfhi(w[i]) * scale;
  }
}

DEV void job_ml_prep(const Params& p, int l, int job, float* sm) {
  const int tid = opaque_tid(), lane = tid & 63, wave = tid >> 6;
  const int i0 = (wave >> 1) * 32, j0 = (wave & 1) * 32, rb = i0 + 4 * (lane >> 5), cc = j0 + (lane & 31);
  const int c = job & 127, bh = job >> 7, b = bh >> 2, h = bh & 3;
  const int t0 = c * 64;
  const u16* proj = (const u16*)(p.ws + OFF_PROJ);
  const float* side = (const float*)(p.ws + OFF_SIDE);
  float* Qs = sm, *Ks = sm + 4160, *Vs = sm + 8320, *Ss = sm + 12480;
  float* vec = sm + 16640;
  float* li = vec, *lf = vec + 64, *cum = vec + 128, *dmx = vec + 192, *wgt = vec + 256, *misc = vec + 320;
  const size_t tokb = (size_t)b * T_ + t0;
  load_blk(proj + tokb * PW_ + 0 + h * 64, Qs, 0.125f);
  load_blk(proj + tokb * PW_ + 256 + h * 64, Ks, 1.f);
  load_blk(proj + tokb * PW_ + 512 + h * 64, Vs, 1.f);
  if (tid < 64) {
    const float* sd = side + (tokb + tid) * 40;
    const float* gb = p.in[9] + l * 8;
    li[tid] = sd[h] + gb[h];
    const float xf = sd[4 + h] + gb[4 + h];
    lf[tid] = fminf(xf, 0.f) - log1pf(expf(-fabsf(xf)));
  }
  if (tid < 64) {
    const float run = wave_scan_add(lf[tid], tid);
    const float pm = wave_scan_max(li[tid] - run, tid);
    cum[tid] = run; dmx[tid] = run + pm;
    if (tid == 63) misc[1] = run;
  }
  __syncthreads();
  const float gtot = misc[1];
  if (tid < 64) {
    const float a = gtot - cum[tid] + li[tid];
    const float ml = wave_max(a);
    wgt[tid] = expf(a - ml);
    if (tid == 0) misc[0] = ml;
  }
  f32x16 acc;
  ZERO16(acc);
  mm64m<false, true>(Qs, Ks, acc, i0, j0, lane);
#pragma unroll
  for (int q = 0; q < 16; ++q) {
    const int t = QROW(q), j = cc;
    Ss[t * 65 + j] = (j <= t) ? acc[q] * expf(cum[t] - cum[j] + li[j] - dmx[t]) : 0.f;
  }
  __syncthreads();
  float* sv = (float*)(p.ws + OFF_MLSV) + (size_t)job * 4096;
  float* kv = (float*)(p.ws + OFF_MLKV) + (size_t)job * 4096;
  float* vo = (float*)(p.ws + OFF_MLVEC) + (size_t)job * 320;
  ZERO16(acc);
  mm64m<false, false>(Ss, Vs, acc, i0, j0, lane);
#pragma unroll
  for (int q = 0; q < 16; ++q) sv[QROW(q) * 64 + cc] = acc[q];
  if (tid < 64) {
    float s = 0.f;
    for (int j = 0; j < 64; ++j) s += Ss[tid * 65 + j];
    vo[0 * 64 + tid] = s; vo[1 * 64 + tid] = dmx[tid]; vo[2 * 64 + tid] = cum[tid];
    if (tid == 0) { vo[4 * 64 + 0] = misc[0]; vo[4 * 64 + 1] = gtot; }
  }
  for (int idx = tid; idx < 4096; idx += 256) { const int j = idx >> 6, d = idx & 63; Ks[j * 65 + d] *= wgt[j]; }
  __syncthreads();
  ZERO16(acc);
  mm64m<true, false>(Ks, Vs, acc, i0, j0, lane);
#pragma unroll
  for (int q = 0; q < 16; ++q) kv[QROW(q) * 64 + cc] = acc[q];
  if (tid < 64) {
    float s = 0.f;
    for (int j = 0; j < 64; ++j) s += Ks[j * 65 + tid];
    vo[3 * 64 + tid] = s;
  }
  __syncthreads();
}

DEV void job_ml_scan(const Params& p, int job) {
  __builtin_amdgcn_s_setprio(3);
  const int tid = opaque_tid();
  const int bh = job / 17, part = job % 17;
  const float* __restrict__ kvb = (const float*)(p.ws + OFF_MLKV) + (size_t)bh * 128 * 4096;
  float* __restrict__ cpb = (float*)(p.ws + OFF_CPREV) + (size_t)bh * 128 * 4096;
  float* __restrict__ npb = (float*)(p.ws + OFF_NPREV) + (size_t)bh * 128 * 64;
  float* vob = (float*)(p.ws + OFF_MLVEC) + (size_t)bh * 128 * 320;
  float m = 0.f, C = 0.f;
  const int idx = part * 256 + tid;
#pragma unroll 8
  for (int c = 0; c < 128; ++c) {
    float* vo = vob + c * 320;
    const float gt = vo[4 * 64 + 1], ml = vo[4 * 64 + 0];
    const float mn = fmaxf(gt + m, ml);
    const float so = expf(gt + m - mn), sn = expf(ml - mn);
    if (part < 16) {
      const float kvv = kvb[(size_t)c * 4096 + idx];
      cpb[(size_t)c * 4096 + idx] = C;
      C = so * C + sn * kvv;
    } else {
      if (tid < 64) { const float nl = vo[3 * 64 + tid]; npb[c * 64 + tid] = C; C = so * C + sn * nl; }
      else if (tid == 64) vo[4 * 64 + 2] = m;
    }
    m = mn;
  }
  __builtin_amdgcn_s_setprio(0);
}

DEV void job_ml_out(const Params& p, int l, int job, float* sm) {
  const int tid = opaque_tid(), ti = tid >> 4, tj = tid & 15;
  const int c = job & 127, bh = job >> 7, b = bh >> 2, h = bh & 3;
  const int t0 = c * 64;
  const u16* proj = (const u16*)(p.ws + OFF_PROJ);
  u16* y = (u16*)(p.ws + OFF_HB);
  float* Qs = sm, *Cs = sm + 4160;
  float* vec = sm + 16640;
  float* rr = vec, *it = vec + 64;
  const size_t tokb = (size_t)b * T_ + t0;
  const float* sv = (const float*)(p.ws + OFF_MLSV) + (size_t)job * 4096;
  const float* cp = (const float*)(p.ws + OFF_CPREV) + (size_t)job * 4096;
  const float* npv = (const float*)(p.ws + OFF_NPREV) + (size_t)job * 64;
  const float* vo = (const float*)(p.ws + OFF_MLVEC) + (size_t)job * 320;
  load_blk(proj + tokb * PW_ + 0 + h * 64, Qs, 0.125f);
  for (int idx = tid; idx < 4096; idx += 256) Cs[(idx >> 6) * 65 + (idx & 63)] = cp[idx];
  const float* nw = p.in[10] + l * 64;
  float svv[4][4], ogv[4][4], nwv[4];
#pragma unroll
  for (int jj = 0; jj < 4; ++jj) nwv[jj] = nw[tj + 16 * jj];
#pragma unroll
  for (int ii = 0; ii < 4; ++ii)
#pragma unroll
    for (int jj = 0; jj < 4; ++jj) {
      const int t = ti + 16 * ii, e = tj + 16 * jj;
      svv[ii][jj] = sv[t * 64 + e];
      ogv[ii][jj] = bf2f(proj[(tokb + t) * PW_ + 768 + h * 64 + e]);
    }
  __builtin_amdgcn_sched_barrier(0);
  __syncthreads();
  if (tid < 64) {
    float qn = 0.f;
    for (int d = 0; d < 64; ++d) qn += Qs[tid * 65 + d] * npv[d];
    const float mprev = vo[4 * 64 + 2];
    const float cumt = vo[2 * 64 + tid], dmax = vo[1 * 64 + tid], ssum = vo[0 * 64 + tid];
    const float minter = cumt + mprev;
    const float mt = fmaxf(minter, dmax);
    const float r = expf(dmax - mt), inter = expf(minter - mt);
    float den = r * ssum + inter * qn;
    den = fmaxf(fabsf(den), expf(-mt));
    rr[tid] = r / den; it[tid] = inter / den;
  }
  float acc[4][4];
  {
    const int lane_ = tid & 63, wave_ = tid >> 6;
    const int i0 = (wave_ >> 1) * 32, j0 = (wave_ & 1) * 32, rb = i0 + 4 * (lane_ >> 5), cc = j0 + (lane_ & 31);
    float* Hs = sm + 8320;
    f32x16 am;
    ZERO16(am);
    mm64m<false, false>(Qs, Cs, am, i0, j0, lane_);
#pragma unroll
    for (int q = 0; q < 16; ++q) Hs[QROW(q) * 65 + cc] = am[q];
    __syncthreads();
#pragma unroll
    for (int ii = 0; ii < 4; ++ii)
#pragma unroll
      for (int jj = 0; jj < 4; ++jj) acc[ii][jj] = Hs[(ti + 16 * ii) * 65 + tj + 16 * jj];
  }
#pragma unroll
  for (int ii = 0; ii < 4; ++ii) {
    const int t = ti + 16 * ii;
    float hv[4]; float ss = 0.f;
#pragma unroll
    for (int jj = 0; jj < 4; ++jj) { hv[jj] = rr[t] * svv[ii][jj] + it[t] * acc[ii][jj]; ss += hv[jj] * hv[jj]; }
    ss = row16_sum(ss);
    const float rs = rsqrtf(ss * (1.f / 64.f) + 1e-6f);
#pragma unroll
    for (int jj = 0; jj < 4; ++jj) {
      const int e = tj + 16 * jj;
      y[(tokb + t) * 1024 + h * 64 + e] = f2bf(sigmoidf_(ogv[ii][jj]) * hv[jj] * rs * nwv[jj]);
    }
  }
  __syncthreads();
}

DEV void gdn_load_conv(const u16* __restrict__ proj, const float* __restrict__ cw, int b, int t0, int h, int which, float* dst, float post, bool l2n) {
  const int tid = opaque_tid(), r = tid >> 2, seg = tid & 3;
  const int ch0 = which * 256 + h * 64 + seg * 16;
  float a[16];
#pragma unroll
  for (int e = 0; e < 16; ++e) a[e] = 0.f;
#pragma unroll
  for (int kk = 0; kk < 4; ++kk) {
    const int tt = t0 + r - 3 + kk;
    if (tt >= 0) {
      const uint4* s = (const uint4*)(proj + ((size_t)b * T_ + tt) * PW_ + 1032 + ch0);
      uint4 u0 = s[0], u1 = s[1];
      uint32_t w[8] = {u0.x, u0.y, u0.z, u0.w, u1.x, u1.y, u1.z, u1.w};
      const float* cwk = cw + kk * 768 + ch0;
#pragma unroll
      for (int i = 0; i < 8; ++i) { a[2 * i] += cwk[2 * i] * bflo(w[i]); a[2 * i + 1] += cwk[2 * i + 1] * bfhi(w[i]); }
    }
  }
  float ss = 0.f;
#pragma unroll
  for (int e = 0; e < 16; ++e) { a[e] = siluf_(a[e]); ss += a[e] * a[e]; }
  float sc = post;
  if (l2n) { ss += __shfl_xor(ss, 1); ss += __shfl_xor(ss, 2); sc = rsqrtf(ss + 1e-6f) * post; }
#pragma unroll
  for (int e = 0; e < 16; ++e) dst[r * 65 + seg * 16 + e] = a[e] * sc;
}

DEV void job_gdn_prep(const Params& p, int l, int job, float* sm) {
  __builtin_amdgcn_s_setprio(1);
  const int tid = opaque_tid(), lane = tid & 63, wave = tid >> 6;
  const int i0 = (wave >> 1) * 32, j0 = (wave & 1) * 32, rb = i0 + 4 * (lane >> 5), cc = j0 + (lane & 31);
  const int c = job & 127, bh = job >> 7, b = bh >> 2, h = bh & 3;
  const int t0 = c * 64;
  const u16* proj = (const u16*)(p.ws + OFF_PROJ);
  const float* side = (const float*)(p.ws + OFF_SIDE);
  const float* cw = p.in[11] + l * 4 * 768;
  float* B1 = sm, *B2 = sm + 4160, *B3 = sm + 8320, *B4 = sm + 12480;
  float* vec = sm + 16640;
  float* bet = vec, *gam = vec + 64, *eg = vec + 128;
  gdn_load_conv(proj, cw, b, t0, h, 1, B1, 1.f, true);
  gdn_load_conv(proj, cw, b, t0, h, 2, B2, 1.f, false);
  if (tid < 64) {
    const float* sd = side + ((size_t)b * T_ + t0 + tid) * 40;
    bet[tid] = sigmoidf_(sd[12 + h]);
    const float x = sd[8 + h] + p.in[13][l * 4 + h];
    const float sp = x > 20.f ? x : log1pf(expf(x));
    const float g = wave_scan_add(-expf(p.in[12][l * 4 + h]) * sp, tid);
    gam[tid] = g; eg[tid] = expf(g);
  }
  __syncthreads();
  f32x16 acc;
  ZERO16(acc);
  mm64m<false, true>(B1, B1, acc, i0, j0, lane);
#pragma unroll
  for (int q = 0; q < 16; ++q) {
    const int t = QROW(q), j = cc;
    B3[t * 65 + j] = (t > j) ? bet[t] * acc[q] * expf(gam[t] - gam[j]) : 0.f;
  }
  __syncthreads();
  if (tid < 128) {
    const bool isU = tid < 64; const int cc = tid & 63;
    float* X = isU ? B2 : B4;
    if (isU) { for (int t = 0; t < 64; ++t) X[t * 65 + cc] *= bet[t]; }
    else { for (int t = 0; t < 64; ++t) X[t * 65 + cc] = bet[t] * eg[t] * B1[t * 65 + cc]; }
    for (int tb = 0; tb < 64; tb += 8) {
      float rr[8];
#pragma unroll
      for (int u = 0; u < 8; ++u) rr[u] = X[(tb + u) * 65 + cc];
#pragma unroll 4
      for (int j = 0; j < tb; ++j) {
        const float xj = X[j * 65 + cc];
#pragma unroll
        for (int u = 0; u < 8; ++u) rr[u] -= B3[(tb + u) * 65 + j] * xj;
      }
#pragma unroll
      for (int u = 1; u < 8; ++u)
#pragma unroll
        for (int v = 0; v < u; ++v) rr[u] -= B3[(tb + u) * 65 + tb + v] * rr[v];
#pragma unroll
      for (int u = 0; u < 8; ++u) X[(tb + u) * 65 + cc] = rr[u];
    }
  }
  __syncthreads();
  gdn_load_conv(proj, cw, b, t0, h, 0, B3, 0.125f, true);
  __syncthreads();
  f32x16 P;
  ZERO16(P);
  mm64m<false, true>(B3, B1, P, i0, j0, lane);
#pragma unroll
  for (int q = 0; q < 16; ++q) {
    const int t = QROW(q), j = cc;
    P[q] = (t >= j) ? P[q] * expf(gam[t] - gam[j]) : 0.f;
  }
  __syncthreads();
  const float g63 = gam[63];
  for (int idx = tid; idx < 4096; idx += 256) { const int ll = idx >> 6, d = idx & 63; B1[ll * 65 + d] *= expf(g63 - gam[ll]); }
  __syncthreads();
  const float gl = eg[63];
  float* Mo = (float*)(p.ws + OFF_GDM) + (size_t)job * 4096;
  float* Bo = (float*)(p.ws + OFF_GDB) + (size_t)job * 4096;
  float* Qo = (float*)(p.ws + OFF_GDQ) + (size_t)job * 4096;
  float* Po = (float*)(p.ws + OFF_GDP) + (size_t)job * 4096;
  ZERO16(acc);
  mm64m<true, false>(B1, B4, acc, i0, j0, lane);
#pragma unroll
  for (int q = 0; q < 16; ++q) { const int d = QROW(q), d2 = cc; Mo[d * 64 + d2] = (d == d2 ? gl : 0.f) - acc[q]; }
  ZERO16(acc);
  mm64m<true, false>(B1, B2, acc, i0, j0, lane);
#pragma unroll
  for (int q = 0; q < 16; ++q) Bo[QROW(q) * 64 + cc] = acc[q];
  __syncthreads();
#pragma unroll
  for (int q = 0; q < 16; ++q) B1[QROW(q) * 65 + cc] = P[q];
  __syncthreads();
  ZERO16(acc);
  mm64m<false, false>(B1, B4, acc, i0, j0, lane);
#pragma unroll
  for (int q = 0; q < 16; ++q) { const int t = QROW(q), d = cc; Qo[t * 64 + d] = B3[t * 65 + d] * eg[t] - acc[q]; }
  ZERO16(acc);
  mm64m<false, false>(B1, B2, acc, i0, j0, lane);
#pragma unroll
  for (int q = 0; q < 16; ++q) Po[QROW(q) * 64 + cc] = acc[q];
  __builtin_amdgcn_s_setprio(0);
  __syncthreads();
}

DEV void job_gdn_scan(const Params& p, int job, float* sm) {
  __builtin_amdgcn_s_setprio(3);
  const int tid = opaque_tid(), d = tid >> 2, e = tid & 3;
  const int bh = job >> 4, slice = job & 15, col = slice * 4 + e;
  const float* Mb = (const float*)(p.ws + OFF_GDM) + (size_t)bh * 128 * 4096;
  const float* Bb = (const float*)(p.ws + OFF_GDB) + (size_t)bh * 128 * 4096 + d * 64 + col;
  float* Sb = (float*)(p.ws + OFF_SPREV) + (size_t)bh * 128 * 4096 + d * 64 + col;
  float* Ml = sm;
  float* Sl = sm + 8704;
  const int lrow = tid >> 4, lc4 = (tid & 15) * 4;
  float S = 0.f;
  float4 a0, a1, a2, a3, b0, b1, b2, b3;
  float bvA, bvB;
#define LOADM(c_, A, B, C, D) { const float4* mp = (const float4*)(Mb + (size_t)(c_) * 4096); A = mp[tid]; B = mp[tid + 256]; C = mp[tid + 512]; D = mp[tid + 768]; }
#define STOREM(st_, A, B, C, D) { float* ml = Ml + (st_) * 4352 + lrow * 68 + lc4; *(float4*)ml = A; *(float4*)(ml + 16 * 68) = B; *(float4*)(ml + 32 * 68) = C; *(float4*)(ml + 48 * 68) = D; }
#define GSTEP(c_, A, B, C, D, BV)                                                        \
  {                                                                                      \
    float* sl = Sl + ((c_) & 1) * 272;                                                   \
    sl[e * 68 + d] = S;                                                                  \
    const float bcur = BV;                                                               \
    Sb[(size_t)(c_) * 4096] = S;                                                         \
    __syncthreads();                                                                     \
    if ((c_) + 1 < 128) STOREM(((c_) + 1) & 1, A, B, C, D);                              \
    if ((c_) + 3 < 128) LOADM((c_) + 3, A, B, C, D);                                     \
    if ((c_) + 2 < 128) BV = Bb[(size_t)((c_) + 2) * 4096];                              \
    __builtin_amdgcn_sched_barrier(0);                                                   \
    const float* mlc = Ml + ((c_) & 1) * 4352 + d * 68;                                  \
    float acc_ = bcur;                                                                   \
    _Pragma("unroll") for (int i = 0; i < 16; ++i) {                                     \
      const float4 m4 = *(const float4*)(mlc + 4 * i);                                   \
      const float4 s4 = *(const float4*)(sl + e * 68 + 4 * i);                           \
      acc_ += m4.x * s4.x + m4.y * s4.y + m4.z * s4.z + m4.w * s4.w;                     \
    }                                                                                    \
    S = acc_;                                                                            \
  }
  LOADM(0, a0, a1, a2, a3);
  STOREM(0, a0, a1, a2, a3);
  LOADM(1, a0, a1, a2, a3);
  LOADM(2, b0, b1, b2, b3);
  bvA = Bb[0]; bvB = Bb[4096];
  for (int c = 0; c < 128; c += 2) {
    GSTEP(c, a0, a1, a2, a3, bvA);
    GSTEP(c + 1, b0, b1, b2, b3, bvB);
  }
#undef LOADM
#undef STOREM
#undef GSTEP
  __builtin_amdgcn_s_setprio(0);
  __syncthreads();
}

DEV void job_gdn_out(const Params& p, int l, int job, float* sm) {
  const int tid = opaque_tid(), ti = tid >> 4, tj = tid & 15;
  const int c = job & 127, bh = job >> 7, b = bh >> 2, h = bh & 3;
  const int t0 = c * 64;
  const u16* proj = (const u16*)(p.ws + OFF_PROJ);
  u16* y = (u16*)(p.ws + OFF_HB);
  float* B1 = sm, *B2 = sm + 4160;
  const float* Qo = (const float*)(p.ws + OFF_GDQ) + (size_t)job * 4096;
  const float* So = (const float*)(p.ws + OFF_SPREV) + (size_t)job * 4096;
  const float* Po = (const float*)(p.ws + OFF_GDP) + (size_t)job * 4096;
  for (int idx = tid; idx < 4096; idx += 256) { B1[(idx >> 6) * 65 + (idx & 63)] = Qo[idx]; B2[(idx >> 6) * 65 + (idx & 63)] = So[idx]; }
  const float* nw = p.in[14] + l * 64;
  const size_t tokb = (size_t)b * T_ + t0;
  float pov[4][4], zv[4][4], nwv[4];
#pragma unroll
  for (int jj = 0; jj < 4; ++jj) nwv[jj] = nw[tj + 16 * jj];
#pragma unroll
  for (int ii = 0; ii < 4; ++ii)
#pragma unroll
    for (int jj = 0; jj < 4; ++jj) {
      const int t = ti + 16 * ii, e = tj + 16 * jj;
      pov[ii][jj] = Po[t * 64 + e];
      zv[ii][jj] = bf2f(proj[(tokb + t) * PW_ + 1800 + h * 64 + e]);
    }
  __builtin_amdgcn_sched_barrier(0);
  __syncthreads();
  float acc[4][4];
  {
    const int lane_ = tid & 63, wave_ = tid >> 6;
    const int i0 = (wave_ >> 1) * 32, j0 = (wave_ & 1) * 32, rb = i0 + 4 * (lane_ >> 5), cc = j0 + (lane_ & 31);
    float* Hs = sm + 8320;
    f32x16 am;
    ZERO16(am);
    mm64m<false, false>(B1, B2, am, i0, j0, lane_);
#pragma unroll
    for (int q = 0; q < 16; ++q) Hs[QROW(q) * 65 + cc] = am[q];
    __syncthreads();
#pragma unroll
    for (int ii = 0; ii < 4; ++ii)
#pragma unroll
      for (int jj = 0; jj < 4; ++jj) acc[ii][jj] = Hs[(ti + 16 * ii) * 65 + tj + 16 * jj];
  }
#pragma unroll
  for (int ii = 0; ii < 4; ++ii) {
    const int t = ti + 16 * ii;
    float ov[4]; float ss = 0.f;
#pragma unroll
    for (int jj = 0; jj < 4; ++jj) { ov[jj] = acc[ii][jj] + pov[ii][jj]; ss += ov[jj] * ov[jj]; }
    ss = row16_sum(ss);
    const float rs = rsqrtf(ss * (1.f / 64.f) + 1e-6f);
#pragma unroll
    for (int jj = 0; jj < 4; ++jj) {
      const int e = tj + 16 * jj;
      y[(tokb + t) * 1024 + 256 + h * 64 + e] = f2bf(ov[jj] * rs * nwv[jj] * siluf_(zv[ii][jj]));
    }
  }
  __syncthreads();
}

DEV void job_nsa_tok(const Params& p, int l, int job) {
  const int tid = opaque_tid(), lane = tid & 63, wave = tid >> 6;
  const int tok = job * 4 + wave, b = tok >> 13, t = tok & 8191;
  const u16* proj = (const u16*)(p.ws + OFF_PROJ);
  u16* qn = (u16*)(p.ws + OFF_QN);
  u16* ks = (u16*)(p.ws + OFF_KS);
  u16* kw = (u16*)(p.ws + OFF_KW);
  const float* qkn = p.in[15] + l * 256;
  const int i = lane & 31;
  const float inv = exp2f(-(float)i * (13.287712379549449f / 32.f));
  const float ang = (float)t * inv;
  const float sn = sinf(ang), cs = cosf(ang);
  float xv[12];
#pragma unroll
  for (int v = 0; v < 12; ++v) {
    const int col = v < 8 ? 2064 + v * 64 : (v < 10 ? 2064 + 512 + 2 * 128 + (v - 8) * 64 : 2064 + 512 + 4 * 128 + (v - 10) * 64);
    xv[v] = bf2f(proj[(size_t)tok * PW_ + col + lane]);
  }
#pragma unroll
  for (int v = 0; v < 12; ++v) {
    int wsel; u16* dst; float post = 1.f;
    if (v < 8) { wsel = 0; dst = qn + (((size_t)(b * 8 + v)) * T_ + t) * 64; post = 0.125f * 1.4426950408889634f; }
    else if (v < 10) { wsel = 2; dst = ks + (((size_t)(b * 2 + v - 8)) * T_ + t) * 64; }
    else { wsel = 3; dst = kw + (((size_t)(b * 2 + v - 10)) * T_ + t) * 64; }
    const float x = xv[v];
    const float ss = wave_sum(x * x);
    const float yv = x * rsqrtf(ss * (1.f / 64.f) + 1e-6f) * qkn[wsel * 64 + lane];
    const float o = __shfl_xor(yv, 32);
    const float out = lane < 32 ? yv * cs - o * sn : o * sn + yv * cs;
    dst[lane] = f2bf(out * post);
  }
}

DEV void job_nsa_vt(const Params& p, int job, unsigned char* smem) {
  const int tid = opaque_tid();
  const int tile = job & 127, bh = (job >> 7) & 3, which = job >> 9;
  const int b = bh >> 1, hkv = bh & 1, t0 = tile * 64;
  const u16* proj = (const u16*)(p.ws + OFF_PROJ);
  u16* vt = (u16*)(p.ws + (which == 0 ? OFF_VST : OFF_VWT));
  const int col = 2064 + 512 + (which == 0 ? 3 : 5) * 128 + hkv * 64;
  u16* sm = (u16*)smem;
  {
    const int rr = tid >> 2, seg = tid & 3;
    const uint4* s = (const uint4*)(proj + ((size_t)b * T_ + t0 + rr) * PW_ + col + seg * 16);
    uint4 a = s[0], bq = s[1];
    uint32_t* d = (uint32_t*)(sm + rr * 66 + seg * 16);
    d[0] = a.x; d[1] = a.y; d[2] = a.z; d[3] = a.w; d[4] = bq.x; d[5] = bq.y; d[6] = bq.z; d[7] = bq.w;
  }
  __syncthreads();
  {
    const int d = tid >> 2, seg = tid & 3;
    uint32_t w[8];
#pragma unroll
    for (int i = 0; i < 8; ++i) w[i] = (uint32_t)sm[(seg * 16 + 2 * i) * 66 + d] | ((uint32_t)sm[(seg * 16 + 2 * i + 1) * 66 + d] << 16);
    uint4* o = (uint4*)(vt + ((size_t)(b * 2 + hkv) * 64 + d) * T_ + t0 + seg * 16);
    o[0] = make_uint4(w[0], w[1], w[2], w[3]);
    o[1] = make_uint4(w[4], w[5], w[6], w[7]);
  }
  __syncthreads();
}

DEV void job_cmp2(const Params& p, int l, int job, float* sm) {
  const int tid = opaque_tid(), lane = tid & 63, wave = tid >> 6;
  const int wjob = job * 4 + wave, prob = wjob >> 9, n = wjob & 511;
  const int b = prob >> 2, hkv = (prob >> 1) & 1, kv = prob & 1;
  const u16* hid = (const u16*)(p.ws + OFF_HID) + ((size_t)prob * 512 + n) * 256;
  float* hrow = sm + wave * 256;
  {
    const uint2 hv = *(const uint2*)(hid + lane * 4);
    hrow[lane * 4 + 0] = bflo(hv.x); hrow[lane * 4 + 1] = bfhi(hv.x);
    hrow[lane * 4 + 2] = bflo(hv.y); hrow[lane * 4 + 3] = bfhi(hv.y);
  }
  __syncthreads();
  const float* w2 = p.in[18] + ((size_t)(l * 2 + kv)) * 256 * 64;
  float o = 0.f;
#pragma unroll 32
  for (int j = 0; j < 256; ++j) o += hrow[j] * w2[j * 64 + lane];
  if (n == 511) o = 0.f;
  if (kv == 0) {
    const float ss = wave_sum(o * o);
    const float yv = o * rsqrtf(ss * (1.f / 64.f) + 1e-6f) * p.in[15][l * 256 + 64 + lane];
    const int i = lane & 31;
    const float inv = exp2f(-(float)i * (13.287712379549449f / 32.f));
    const float ang = (float)(16 * n + 31) * inv;
    const float sn = sinf(ang), cs = cosf(ang);
    const float ot = __shfl_xor(yv, 32);
    float out = lane < 32 ? yv * cs - ot * sn : ot * sn + yv * cs;
    if (n == 511) out = 0.f;
    ((u16*)(p.ws + OFF_KC))[((size_t)(b * 2 + hkv) * 512 + n) * 64 + lane] = f2bf(out);
  } else {
    ((u16*)(p.ws + OFF_VCT))[((size_t)(b * 2 + hkv) * 64 + lane) * 512 + n] = f2bf(o);
  }
  __syncthreads();
}

template <int MODE, bool IMP>
DEV void nsa_loop(u16* Ks, u16* Vs, const u16* __restrict__ kb, const u16* __restrict__ vb, int vstride,
                  int ntile, int tile_lo, const int* tlist, const bf16x8 (&qf)[4], int t, int t0, int c, int h,
                  float& m, float& lsum, f32x16 (&acc)[2], uint32_t sw0, uint32_t sw1, uint32_t sw2, uint32_t sw3,
                  float* imp, int tl, float inv_l) {
  const int tid = opaque_tid();
  uint4 rk0, rk1, rv0, rv1;
  const int lrow0 = tid >> 3, lpart = tid & 7, lrow1 = lrow0 + 32;
#define TILEID(idx_) (MODE == 1 ? tlist[idx_] : tile_lo + (idx_))
#define NGLOAD(tix_)                                                                     \
  {                                                                                      \
    const int key0_ = (tix_) * 64;                                                       \
    rk0 = *(const uint4*)(kb + (size_t)(key0_ + lrow0) * 64 + lpart * 8);                \
    rk1 = *(const uint4*)(kb + (size_t)(key0_ + lrow1) * 64 + lpart * 8);                \
    if (!IMP) {                                                                          \
      rv0 = *(const uint4*)(vb + (size_t)lrow0 * vstride + key0_ + lpart * 8);           \
      rv1 = *(const uint4*)(vb + (size_t)lrow1 * vstride + key0_ + lpart * 8);           \
    }                                                                                    \
  }
#define NSSTORE(buf_)                                                                    \
  {                                                                                      \
    *(uint4*)(Ks + ((buf_) * 64 + lrow0) * 72 + lpart * 8) = rk0;                        \
    *(uint4*)(Ks + ((buf_) * 64 + lrow1) * 72 + lpart * 8) = rk1;                        \
    if (!IMP) {                                                                          \
      *(uint4*)(Vs + ((buf_) * 64 + lrow0) * 72 + lpart * 8) = rv0;                      \
      *(uint4*)(Vs + ((buf_) * 64 + lrow1) * 72 + lpart * 8) = rv1;                      \
    }                                                                                    \
  }
  NGLOAD(TILEID(0));
  NSSTORE(0);
  __syncthreads();
  for (int idx = 0; idx < ntile; ++idx) {
    const int buf = idx & 1;
    const int tix = TILEID(idx);
    const int key0 = tix * 64;
    if (idx + 1 < ntile) NGLOAD(TILEID(idx + 1));
    __builtin_amdgcn_sched_barrier(0);
    bool tv = true;
    if (MODE == 1) {
      const int w = tix >> 5;
      const uint32_t sw = w == 0 ? sw0 : (w == 1 ? sw1 : (w == 2 ? sw2 : sw3));
      tv = (sw >> (tix & 31)) & 1u;
    }
    const bool wave_any = (MODE != 1) || (__builtin_amdgcn_ballot_w64(tv) != 0ull);
    if (wave_any) {
    f32x16 s[2];
#pragma unroll
    for (int kt = 0; kt < 2; ++kt) {
#pragma unroll
      for (int i = 0; i < 16; ++i) s[kt][i] = 0.f;
#pragma unroll
      for (int ks = 0; ks < 4; ++ks) {
        const bf16x8 a = *(const bf16x8*)(Ks + (buf * 64 + kt * 32 + c) * 72 + ks * 16 + 8 * h);
        s[kt] = __builtin_amdgcn_mfma_f32_32x32x16_bf16(a, qf[ks], s[kt], 0, 0, 0);
      }
    }
    bool need_mask;
    if (MODE == 0) need_mask = !(16 * (key0 + 63) + 31 <= t0);
    else if (MODE == 1) need_mask = (key0 + 63 > t0);
    else need_mask = !((key0 + 63 <= t0) && (key0 + 512 > t0 + 31));
    if (IMP) need_mask = true;
    float mx = -1e30f;
    if (need_mask) {
#pragma unroll
      for (int kt = 0; kt < 2; ++kt)
#pragma unroll
        for (int i = 0; i < 16; ++i) {
          const int key = key0 + kt * 32 + (i & 3) + 8 * (i >> 2) + 4 * h;
          bool v;
          if (MODE == 0) v = (16 * key + 31 <= t);
          else if (MODE == 1) v = tv && (key <= t);
          else v = (key <= t) && (key + 512 > t);
          const float sv = v ? s[kt][i] : -1e30f;
          s[kt][i] = sv;
          mx = fmaxf(mx, sv);
        }
    } else {
#pragma unroll
      for (int kt = 0; kt < 2; ++kt)
#pragma unroll
        for (int i = 0; i < 16; ++i) mx = fmaxf(mx, s[kt][i]);
      if (MODE == 1 && !tv) mx = -1e30f;
    }
    if (!IMP) {
      mx = fmaxf(mx, __shfl_xor(mx, 32));
      const bool grew = __builtin_amdgcn_ballot_w64(mx > m + 8.0f) != 0ull;
      float mn = m, alpha = 1.f;
      if (grew) { mn = fmaxf(m, mx); alpha = __builtin_amdgcn_exp2f(m - mn); m = mn; }
      float ps = 0.f;
      if (need_mask) {
#pragma unroll
        for (int kt = 0; kt < 2; ++kt)
#pragma unroll
          for (int i = 0; i < 16; ++i) {
            const float pv = s[kt][i] > -1e29f ? __builtin_amdgcn_exp2f(s[kt][i] - mn) : 0.f;
            s[kt][i] = pv; ps += pv;
          }
      } else {
        const float msub = (MODE == 1 && !tv) ? 1e30f : mn;
#pragma unroll
        for (int kt = 0; kt < 2; ++kt)
#pragma unroll
          for (int i = 0; i < 16; ++i) {
            const float pv = __builtin_amdgcn_exp2f(s[kt][i] - msub);
            s[kt][i] = pv; ps += pv;
          }
      }
      lsum = lsum * alpha + ps;
      if (grew) {
#pragma unroll
        for (int i = 0; i < 16; ++i) { acc[0][i] *= alpha; acc[1][i] *= alpha; }
      }
#pragma unroll
      for (int kt = 0; kt < 2; ++kt)
#pragma unroll
        for (int s2 = 0; s2 < 2; ++s2) {
          union { u32x4 u; bf16x8 v; } pf;
          pf.u[0] = cvtpk(s[kt][8 * s2 + 0], s[kt][8 * s2 + 1]);
          pf.u[1] = cvtpk(s[kt][8 * s2 + 2], s[kt][8 * s2 + 3]);
          pf.u[2] = cvtpk(s[kt][8 * s2 + 4], s[kt][8 * s2 + 5]);
          pf.u[3] = cvtpk(s[kt][8 * s2 + 6], s[kt][8 * s2 + 7]);
#pragma unroll
          for (int dt = 0; dt < 2; ++dt) {
            const u16* vp = Vs + (buf * 64 + dt * 32 + c) * 72 + kt * 32 + 16 * s2 + 4 * h;
            const uint2 lo = *(const uint2*)vp;
            const uint2 hi = *(const uint2*)(vp + 8);
            union { u32x4 u; bf16x8 v; } af;
            af.u[0] = lo.x; af.u[1] = lo.y; af.u[2] = hi.x; af.u[3] = hi.y;
            acc[dt] = __builtin_amdgcn_mfma_f32_32x32x16_bf16(af.v, pf.v, acc[dt], 0, 0, 0);
          }
        }
    } else {
#pragma unroll
      for (int kt = 0; kt < 2; ++kt)
#pragma unroll
        for (int q4 = 0; q4 < 4; ++q4) {
          float pr[4];
#pragma unroll
          for (int e = 0; e < 4; ++e) {
            const float sv = s[kt][4 * q4 + e];
            pr[e] = sv > -1e29f ? __builtin_amdgcn_exp2f(sv - m) * inv_l : 0.f;
          }
          float a = pr[0] + pr[1] + pr[2] + 0.5f * pr[3];
          float bq = 0.5f * pr[3];
          a += dpp_f(a, 0); a += dpp_f(a, 1);
          bq += dpp_f(bq, 0); bq += dpp_f(bq, 1);
          if ((c & 3) == 0) {
            const int mi = (key0 + kt * 32 + 8 * q4 + 4 * h) >> 2;
            atomicAdd(&imp[tl * 129 + mi], a);
            if (mi + 1 < 128) atomicAdd(&imp[tl * 129 + mi + 1], bq);
          }
        }
    }
    }
    if (idx + 1 < ntile) NSSTORE(buf ^ 1);
    __syncthreads();
  }
#undef TILEID
#undef NGLOAD
#undef NSSTORE
}

template <bool FIRST>
DEV void nsa_emit(u16* y, f32x16 (&acc)[2], int h) {
#pragma unroll
  for (int dt = 0; dt < 2; ++dt)
#pragma unroll
    for (int i4 = 0; i4 < 4; ++i4) {
      const int d = dt * 32 + 8 * i4 + 4 * h;
      float v0 = acc[dt][4 * i4 + 0], v1 = acc[dt][4 * i4 + 1], v2 = acc[dt][4 * i4 + 2], v3 = acc[dt][4 * i4 + 3];
      if (!FIRST) {
        const uint2 o = *(const uint2*)(y + d);
        v0 += bflo(o.x); v1 += bfhi(o.x); v2 += bflo(o.y); v3 += bfhi(o.y);
      }
      *(uint2*)(y + d) = make_uint2(pack2(v0, v1), pack2(v2, v3));
    }
#pragma unroll
  for (int i = 0; i < 16; ++i) { acc[0][i] = 0.f; acc[1][i] = 0.f; }
}

DEV void job_nsa_attn(const Params& p, int l, int job, unsigned char* smem) {
  const int tid = opaque_tid(), lane = tid & 63, wave = tid >> 6;
  const int c = lane & 31, h = lane >> 5;
  const int tile = 255 - (job >> 2), bh = job & 3, b = bh >> 1, hkv = bh & 1;
  const int t0 = tile * 32, cur = t0 >> 6;
  const int tl = wave * 8 + (c >> 2), g = c & 3, head = hkv * 4 + g;
  const int t = t0 + tl;
  const size_t tok = (size_t)b * T_ + t;
  u16* Ks = (u16*)smem;
  u16* Vs = Ks + 2 * 64 * 72;
  float* imp = (float*)(smem + 36864);
  uint32_t* selm = (uint32_t*)(smem + 36864 + 16512);
  int* tlist = (int*)(smem + 36864 + 16512 + 512);
  int* misc = tlist + 128;
  uint32_t* unim = (uint32_t*)(misc + 4);
  const u16* qn = (const u16*)(p.ws + OFF_QN);
  const u16* qptr = qn + (((size_t)(b * 8 + head)) * T_ + t) * 64;
  bf16x8 qf[4];
#pragma unroll
  for (int ks = 0; ks < 4; ++ks) qf[ks] = *(const bf16x8*)(qptr + ks * 16 + 8 * h);
  const float* sd = (const float*)(p.ws + OFF_SIDE) + tok * 40 + 16;
  const float g0 = sigmoidf_(sd[head]), g1 = sigmoidf_(sd[8 + head]), g2 = sigmoidf_(sd[16 + head]);
  f32x16 acc[2];
#pragma unroll
  for (int i = 0; i < 16; ++i) { acc[0][i] = 0.f; acc[1][i] = 0.f; }
  u16* y = (u16*)(p.ws + OFF_HB) + tok * 1024 + 512 + head * 64;
  const int bk = b * 2 + hkv;
  const u16* kc = (const u16*)(p.ws + OFF_KC) + (size_t)bk * 512 * 64;
  const u16* vct = (const u16*)(p.ws + OFF_VCT) + (size_t)bk * 64 * 512;
  const int ncmp = (t0 >> 10) + 1;
  float m = -1e30f, ls = 0.f;
  nsa_loop<0, false>(Ks, Vs, kc, vct, 512, ncmp, 0, tlist, qf, t, t0, c, h, m, ls, acc, 0u, 0u, 0u, 0u, imp, tl, 0.f);
  {
    const float lt = ls + __shfl_xor(ls, 32);
    const float inv = lt > 0.f ? 1.f / lt : 0.f;
    const float f = g0 * inv;
#pragma unroll
    for (int i = 0; i < 16; ++i) { acc[0][i] *= f; acc[1][i] *= f; }
    nsa_emit<true>(y, acc, h);
    int ntl;
    if (cur >= 16) {
      for (int idx = tid; idx < 32 * 129; idx += 256) imp[idx] = 0.f;
      if (tid < 128) selm[tid] = 0u;
      __syncthreads();
      float dm = 0.f;
      nsa_loop<0, true>(Ks, Vs, kc, vct, 512, ncmp, 0, tlist, qf, t, t0, c, h, m, dm, acc, 0u, 0u, 0u, 0u, imp, tl, inv);
      {
        const int hiC = cur - 2;
        float v1[8], v2[8];
        uint32_t mk[8][4];
#pragma unroll
        for (int q = 0; q < 8; ++q) {
          const float* row = imp + (wave * 8 + q) * 129;
          v1[q] = (lane >= 1 && lane <= hiC) ? row[lane] : -1.f;
          v2[q] = (lane + 64 <= hiC) ? row[lane + 64] : -1.f;
          mk[q][0] = 1u; mk[q][1] = 0u; mk[q][2] = 0u; mk[q][3] = 0u;
        }
        for (int rnd = 0; rnd < 13; ++rnd) {
          float wm[8];
#pragma unroll
          for (int q = 0; q < 8; ++q) wm[q] = fmaxf(v1[q], v2[q]);
#pragma unroll
          for (int q = 0; q < 8; ++q) wm[q] = wave_max_valu(wm[q]);
#pragma unroll
          for (int q = 0; q < 8; ++q) {
            const unsigned long long bl1 = __builtin_amdgcn_ballot_w64(v1[q] == wm[q]);
            const unsigned long long bl2 = __builtin_amdgcn_ballot_w64(v2[q] == wm[q]);
            int selj;
            if (bl1 != 0ull) { const int ow = __builtin_ctzll(bl1); if (lane == ow) v1[q] = -1.f; selj = ow; }
            else { const int ow = __builtin_ctzll(bl2); if (lane == ow) v2[q] = -1.f; selj = ow + 64; }
            const uint32_t bit = 1u << (selj & 31);
            const int wsel = selj >> 5;
            mk[q][0] |= wsel == 0 ? bit : 0u; mk[q][1] |= wsel == 1 ? bit : 0u;
            mk[q][2] |= wsel == 2 ? bit : 0u; mk[q][3] |= wsel == 3 ? bit : 0u;
          }
        }
        if (lane == 0) {
#pragma unroll
          for (int q = 0; q < 8; ++q) {
            uint32_t f0 = mk[q][0], f1 = mk[q][1], f2 = mk[q][2], f3 = mk[q][3];
#pragma unroll
            for (int z = 0; z < 2; ++z) {
              const int jf = cur - z; const uint32_t bit = 1u << (jf & 31); const int wsel = jf >> 5;
              f0 |= wsel == 0 ? bit : 0u; f1 |= wsel == 1 ? bit : 0u; f2 |= wsel == 2 ? bit : 0u; f3 |= wsel == 3 ? bit : 0u;
            }
            uint32_t* sp = selm + (wave * 8 + q) * 4;
            sp[0] = f0; sp[1] = f1; sp[2] = f2; sp[3] = f3;
          }
        }
      }
      __syncthreads();
      if (tid < 4) unim[tid] = 0u;
      __syncthreads();
      if (tid < 128) atomicOr(&unim[tid & 3], selm[tid]);
      __syncthreads();
      if (tid < 128) {
        const uint32_t u0 = unim[0], u1 = unim[1], u2 = unim[2], u3 = unim[3];
        const int j = tid, w = j >> 5;
        const uint32_t uw = w == 0 ? u0 : (w == 1 ? u1 : (w == 2 ? u2 : u3));
        const int below = (w > 0 ? __popc(u0) : 0) + (w > 1 ? __popc(u1) : 0) + (w > 2 ? __popc(u2) : 0) + __popc(uw & ((1u << (j & 31)) - 1u));
        if (j <= cur && ((uw >> (j & 31)) & 1u)) tlist[below] = j;
        if (j == 0) misc[0] = __popc(u0) + __popc(u1) + __popc(u2) + __popc(u3);
      }
      __syncthreads();
      ntl = misc[0];
    } else {
      if (tid < 128) { tlist[tid] = tid; selm[tid] = 0xffffffffu; }
      __syncthreads();
      ntl = cur + 1;
    }
    const uint32_t sw0 = selm[tl * 4 + 0], sw1 = selm[tl * 4 + 1], sw2 = selm[tl * 4 + 2], sw3 = selm[tl * 4 + 3];
    const u16* ksb = (const u16*)(p.ws + OFF_KS) + (size_t)bk * T_ * 64;
    const u16* vsb = (const u16*)(p.ws + OFF_VST) + (size_t)bk * 64 * T_;
    m = -1e30f; ls = 0.f;
    nsa_loop<1, false>(Ks, Vs, ksb, vsb, T_, ntl, 0, tlist, qf, t, t0, c, h, m, ls, acc, sw0, sw1, sw2, sw3, imp, tl, 0.f);
    {
      const float lt2 = ls + __shfl_xor(ls, 32);
      const float f2 = g1 / lt2;
#pragma unroll
      for (int i = 0; i < 16; ++i) { acc[0][i] *= f2; acc[1][i] *= f2; }
      nsa_emit<false>(y, acc, h);
    }
  }
  {
    const u16* kwb = (const u16*)(p.ws + OFF_KW) + (size_t)bk * T_ * 64;
    const u16* vwb = (const u16*)(p.ws + OFF_VWT) + (size_t)bk * 64 * T_;
    const int lo = (t0 - 511 > 0 ? t0 - 511 : 0) >> 6;
    m = -1e30f; ls = 0.f;
    nsa_loop<2, false>(Ks, Vs, kwb, vwb, T_, cur - lo + 1, lo, tlist, qf, t, t0, c, h, m, ls, acc, 0u, 0u, 0u, 0u, imp, tl, 0.f);
    const float lt3 = ls + __shfl_xor(ls, 32);
    const float f3 = g2 / lt3;
#pragma unroll
    for (int i = 0; i < 16; ++i) { acc[0][i] *= f3; acc[1][i] *= f3; }
    nsa_emit<false>(y, acc, h);
  }
  __syncthreads();
}


#define XB_TMO      128
#define XB_XCNT(j)  (256  + 64 * (j))
#define XB_XSUB(j)  (1280 + 64 * (j))
#define XB_XGEN(j)  (2304 + 64 * (j))
#define XB_TOP      3328
#define XB_TOPGEN   3392
#define XCD_BAR_WORDS 3456
#define XB_RANKW(j) (3456 + 64 * (j))
#define XB_ALL_WORDS (3456 + 64 * 16 + 64 * 6)
#define XB_QUEUE(k) (3456 + 64 * 16 + 64 * (k))
#define XB_SPIN_CAP (1u << 18)
#define LAS __attribute__((address_space(3)))
DEV unsigned xb_ld(unsigned* p)              { return __hip_atomic_load(p, __ATOMIC_RELAXED, __HIP_MEMORY_SCOPE_AGENT); }
DEV unsigned xb_add(unsigned* p, unsigned v) { return __hip_atomic_fetch_add(p, v, __ATOMIC_RELAXED, __HIP_MEMORY_SCOPE_AGENT); }
DEV unsigned xb_xcc_id() { return (unsigned)__builtin_amdgcn_s_getreg((3 << 11) | 20) & 0xFu; }
#define XB_SPIN(cond, bar) do { unsigned _sp = 0; while (cond) { __builtin_amdgcn_s_sleep(1); \
    if ((++_sp & 255u) == 0u) { if (xb_ld(&(bar)[XB_TMO])) break; if (_sp > XB_SPIN_CAP) { atomicAdd(&(bar)[XB_TMO], 1u); break; } } } } while (0)
struct XcdBarrier { unsigned* bar; unsigned x; volatile LAS unsigned* st; };
DEV XcdBarrier xcd_barrier_post(unsigned* bar, volatile LAS unsigned* st) {
  XcdBarrier b; b.bar = bar; b.x = xb_xcc_id(); b.st = st;
  if (threadIdx.x == 0) (void)xb_add(&bar[XB_XCNT(b.x)], 1u);
  return b;
}
DEV void xcd_barrier_complete(unsigned* bar, unsigned x, unsigned& nloc, unsigned& nx) {
  const unsigned G = gridDim.x * gridDim.y * gridDim.z;
  unsigned sum, cnt, mine, sp = 0u;
  for (;;) {
    sum = 0u; cnt = 0u; mine = 0u;
#pragma unroll
    for (unsigned j = 0; j < 16; ++j) { const unsigned c = xb_ld(&bar[XB_XCNT(j)]); sum += c; cnt += (c > 0u) ? 1u : 0u; mine = (j == x) ? c : mine; }
    if (sum == G) break;
    __builtin_amdgcn_s_sleep(1);
    if ((++sp & 255u) == 0u) { if (xb_ld(&bar[XB_TMO])) break; if (sp > XB_SPIN_CAP) { atomicAdd(&bar[XB_TMO], 1u); break; } }
  }
  nloc = mine > 0u ? mine : 1u; nx = cnt > 0u ? cnt : 1u;
}
DEV void xcd_barrier(const XcdBarrier& b) {
  asm volatile("s_waitcnt vmcnt(0)" ::: "memory");
  __syncthreads();
  if (threadIdx.x == 0) {
    unsigned* bar = b.bar;
    __builtin_amdgcn_s_waitcnt(0);
    unsigned nloc = b.st[0], nx = b.st[1];
    if (nloc == 0u) { xcd_barrier_complete(bar, b.x, nloc, nx); b.st[0] = nloc; b.st[1] = nx; }
    const unsigned old = xb_add(&bar[XB_XSUB(b.x)], 1u);
    const unsigned gen = old / nloc;
    if (old + 1u == (gen + 1u) * nloc) {
      __builtin_amdgcn_fence(__ATOMIC_RELEASE, "agent");
      asm volatile("s_waitcnt vmcnt(0)" ::: "memory");
      const unsigned og = xb_add(&bar[XB_TOP], 1u);
      const unsigned tg = og / nx;
      if (og + 1u == (tg + 1u) * nx) xb_add(&bar[XB_TOPGEN], 1u);
      else XB_SPIN(xb_ld(&bar[XB_TOPGEN]) == tg, bar);
      __builtin_amdgcn_fence(__ATOMIC_ACQUIRE, "agent");
      xb_add(&bar[XB_XGEN(b.x)], 1u);
      asm volatile("s_waitcnt vmcnt(0)" ::: "memory");
    } else {
      XB_SPIN(xb_ld(&bar[XB_XGEN(b.x)]) == gen, bar);
      __builtin_amdgcn_fence(__ATOMIC_ACQUIRE, "agent");
      asm volatile("s_waitcnt vmcnt(0)" ::: "memory");
    }
  }
  __syncthreads();
}

DEV void wt_ffn_job(const Params& p, int l, int f, int j, float* smf) {
  u16* wt = (u16*)(p.ws + (f == 0 ? OFF_WT : OFF_WTC));
  if (j < 1408) {
    const int rt = j >> 4, ktile = j & 15;
    job_wt(p.in[5] + (size_t)(l * 2 + f) * 1024 * 5632, 5632, wt + WT_UP / 2, 1024, ktile * 64, rt * 64, 1, 0, smf);
  } else {
    const int jj = j - 1408, rt = jj / 44, ktile = jj % 44;
    job_wt(p.in[6] + (size_t)(l * 2 + f) * 2816 * 1024, 1024, wt + WT_DOWN / 2, 2816, ktile * 64, rt * 64, 0, 1024, smf);
  }
}
DEV void wt_mix_job(const Params& p, int l, int j, float* smf) {
  u16* wt = (u16*)(p.ws + OFF_WTB);
  if (j < 864) {
    const int rt = j >> 4, ktile = j & 15;
    job_wt(p.in[7] + (size_t)l * 1024 * INW_, INW_, wt + WT_IN / 2, 1024, ktile * 64, rt * 64, 0, INW_, smf);
  } else if (j < 864 + 256) {
    const int jj = j - 864, rt = jj >> 4, ktile = jj & 15;
    job_wt(p.in[8] + (size_t)l * 1024 * 1024, 1024, wt + WT_OUT / 2, 1024, ktile * 64, rt * 64, 0, 1024, smf);
  } else {
    const int jj = j - 1120, kv = jj >> 7, q = jj & 127, rt = q >> 5, ktile = q & 31;
    job_wt(p.in[17] + (size_t)(l * 2 + kv) * 2048 * 256, 256, wt + WT_W1 / 2 + (size_t)kv * 256 * 2048, 2048, ktile * 64, rt * 64, 0, 256, smf);
  }
}

#define GEMM_TILE_LOOP(NT_, BODY)                                                         \
  {                                                                                       \
    if (bid >= (nb >> 1)) __builtin_amdgcn_s_sleep(13);     \
    const int sn4_ = ((NT_) + 3) >> 2;                                                    \
    const int totS_ = 16 * sn4_;                                                          \
    const int nloc_ = (int)xb.st[0], nx_ = (int)xb.st[1], rank_ = (int)xb.st[2], x_ = (int)xb.x; \
    if (nx_ == 8 && x_ < 8 && (totS_ & 7) == 0 && nloc_ > 0) {                            \
      const int cnt_ = totS_ >> 3, s0_ = x_ * cnt_;                                       \
      for (int o_ = rank_; o_ < cnt_ * 32; o_ += nloc_) {                                 \
        const int S_ = s0_ + (o_ >> 5), w_ = o_ & 31;                                     \
        const int mt_ = (S_ / sn4_) * 8 + (w_ >> 2), nt_ = (S_ % sn4_) * 4 + (w_ & 3);    \
        if (nt_ < (NT_)) { BODY; }                                                        \
      }                                                                                   \
    } else {                                                                              \
      for (int j_ = bid; j_ < 128 * (NT_); j_ += nb) { const int mt_ = j_ / (NT_), nt_ = j_ % (NT_); BODY; } \
    }                                                                                     \
  }

#define DYN_LOOP(QI_, NJOBS_, ...)                                                       \
  for (;;) {                                                                             \
    if (threadIdx.x == 0) xb.st[3] = atomicAdd(&barw[XB_QUEUE(QI_)], 1u);                \
    __syncthreads();                                                                     \
    const int j = (int)xb.st[3];                                                         \
    __syncthreads();                                                                     \
    if (j >= (NJOBS_)) break;                                                            \
    __VA_ARGS__                                                                          \
  }

__global__ void __launch_bounds__(256, 2) fwd_megakernel(Params p) {
  extern __shared__ __attribute__((aligned(16))) unsigned char smem[];
  float* smf = (float*)smem;
  cg::grid_group grid = cg::this_grid();
  const int nb = gridDim.x, bid = blockIdx.x;
  float* mod = (float*)(p.ws + OFF_MOD);
  u16* hb = (u16*)(p.ws + OFF_HB);
  u16* wtb = (u16*)(p.ws + OFF_WTB);
  u16* act = (u16*)(p.ws + OFF_ACT);
  u16* proj = (u16*)(p.ws + OFF_PROJ);
  float* side = (float*)(p.ws + OFF_SIDE);

  unsigned* barw = (unsigned*)(p.ws + OFF_BAR);
  if (bid == nb - 1) { for (int i = threadIdx.x; i < XB_ALL_WORDS; i += 256) barw[i] = 0u; }
  if (threadIdx.x == 0) { ((volatile unsigned*)(smem + LDS_BYTES - 16))[0] = 0u; ((volatile unsigned*)(smem + LDS_BYTES - 16))[1] = 0u; }
  for (int j = bid; j < 288 + 16; j += nb) { if (j < 288) job_mod(p, j, smf); else job_bias1(p, j - 288, smf); }
  {
    const int nconv = 2112 + 1376;
    if (nb > 304 && bid >= 304) {
      const int nw_ = nb - 304, share = (nconv * 5 / 6) / nw_;
      for (int k = 0; k < share; ++k) { const int cj = (bid - 304) + nw_ * k; if (cj < 2112) wt_ffn_job(p, 0, 0, cj, smf); else wt_mix_job(p, 0, cj - 2112, smf); }
      for (int cj = nw_ * share + bid; cj < nconv; cj += nb) { if (cj < 2112) wt_ffn_job(p, 0, 0, cj, smf); else wt_mix_job(p, 0, cj - 2112, smf); }
    } else {
      const int nw_ = nb > 304 ? nb - 304 : 0, share = nw_ > 0 ? (nconv * 5 / 6) / nw_ : 0;
      for (int cj = nw_ * share + bid; cj < nconv; cj += nb) { if (cj < 2112) wt_ffn_job(p, 0, 0, cj, smf); else wt_mix_job(p, 0, cj - 2112, smf); }
    }
  }
  grid.sync();
  const XcdBarrier xb = xcd_barrier_post(barw, (volatile LAS unsigned*)(smem + LDS_BYTES - 16));
  if (threadIdx.x == 0) xb.st[2] = xb_add(&barw[XB_RANKW(xb.x)], 1u);
#define GSYNC() xcd_barrier(xb)

  for (int l = 0; l < 2; ++l) {
    const float* modl = mod + l * 2 * 9216;
    const float* nwl = p.in[4] + l * 3 * 1024;
    for (int f = 0; f < 2; ++f) {
      if (f == 1) {
        for (int j = bid; j < 4096; j += nb) job_adaln(p.out, nwl + 1024, modl, 1, hb, j);
        GSYNC();
        {
          ALplain al{hb, 1024};
          EpiIn epi{proj, side};
          GEMM_TILE_LOOP(27, gemm_tile(smem, al, wtb + WT_IN / 2, 1024, 16, epi, mt_ * 128, nt_ * 128));
        }
        GSYNC();
        DYN_LOOP(l * 2 + 0, 64 + 1024 + 1024 + 640, {
          if (j >= 2112) {
            for (int jl = 2112 + (j - 2112) * 8, je = jl + 8; jl < je; ++jl) {
              if (jl < 6208) job_nsa_tok(p, l, jl - 2112);
              else job_nsa_vt(p, jl - 6208, smem);
            }
          } else
          if (j >= 64 && j < 1088) { SK_GDNPREP(job_gdn_prep(p, l, j - 64, smf);) }
          else if (j < 64) {
            const int q = j, prob = q >> 3, mt = (q >> 1) & 3, nt = q & 1;
            const int b = prob >> 2, hkv = (prob >> 1) & 1, kv = prob & 1;
            ALcmp al{proj + (size_t)b * T_ * PW_ + 2576 + kv * 128 + hkv * 64};
            EpiHid epi{(u16*)(p.ws + OFF_HID) + (size_t)prob * 512 * 256, (const float*)(p.ws + OFF_B1) + (l * 2 + kv) * 256};
            gemm_tile(smem, al, wtb + WT_W1 / 2 + (size_t)kv * 256 * 2048, 2048, 32, epi, mt * 128, nt * 128);
          }
          else if (j < 2112) { SK_MLPREP(job_ml_prep(p, l, j - 1088, smf);) }
        })
        GSYNC();
        DYN_LOOP(4 + l, 128 + 136 + 1024 + 2112 + (l == 0 ? 2112 : 0), {
          if (j < 128) { SK_GDNSCAN(job_gdn_scan(p, j, smf);) }
          else if (j < 264) job_ml_scan(p, j - 128);
          else if (j < 1288) job_cmp2(p, l, j - 264, smf);
          else if (j < 3400) wt_ffn_job(p, l, 1, j - 1288, smf);
          else wt_ffn_job(p, 1, 0, j - 3400, smf);
        })
        GSYNC();
        DYN_LOOP(l * 2 + 1, 3072, {
          if (j < 1024) { SK_NSA(job_nsa_attn(p, l, j, smem);) }
          else if (j < 2048) { SK_MLOUT(job_ml_out(p, l, j - 1024, smf);) }
          else { SK_GDNOUT(job_gdn_out(p, l, j - 2048, smf);) }
        })
        GSYNC();
        {
          ALplain al{hb, 1024};
          EpiRes epi{p.out, p.out, modl + 5 * 1024, 1.0f};
          GEMM_TILE_LOOP(8, gemm_tile(smem, al, wtb + WT_OUT / 2, 1024, 16, epi, mt_ * 128, nt_ * 128));
        }
        GSYNC();
      }
      const int sub = f * 2;
      const float* xsrc = (l == 0 && f == 0) ? p.in[0] : p.out;
      for (int j = bid; j < 4096 + ((l == 0 && f == 1) ? 1376 : 0); j += nb) {
        if (j < 4096) job_adaln(xsrc, nwl + sub * 1024, modl, sub, hb, j);
        else wt_mix_job(p, 1, j - 4096, smf);
      }
      GSYNC();
      u16* wt = (u16*)(p.ws + (f == 0 ? OFF_WT : OFF_WTC));
      {
        ALplain al{hb, 1024};
        EpiUp epi{act};
        GEMM_TILE_LOOP(44, gemm_tile(smem, al, wt + WT_UP / 2, 1024, 16, epi, mt_ * 128, nt_ * 128));
      }
      GSYNC();
      {
        ALplain al{act, DFF_};
        EpiRes epi{xsrc, p.out, modl + (3 * sub + 2) * 1024, 0.5f};
        GEMM_TILE_LOOP(8, gemm_tile(smem, al, wt + WT_DOWN / 2, DFF_, 44, epi, mt_ * 128, nt_ * 128));
      }
      GSYNC();
    }
  }
}

extern "C" void kernel_launch(void* const* d_in, const int* in_sizes, int n_in, void* d_out, int out_size, void* d_ws, size_t ws_size, hipStream_t stream) {
  static int grid_blocks = 0;
  if (!grid_blocks) {
    int dev = 0, cus = 0, per_cu = 0;
    hipGetDevice(&dev);
    hipDeviceGetAttribute(&cus, hipDeviceAttributeMultiprocessorCount, dev);
    hipFuncSetAttribute((const void*)fwd_megakernel, hipFuncAttributeMaxDynamicSharedMemorySize, LDS_BYTES);
    hipOccupancyMaxActiveBlocksPerMultiprocessor(&per_cu, (const void*)fwd_megakernel, 256, LDS_BYTES);
    if (per_cu < 1) per_cu = 1;
    if (per_cu > 2) per_cu = 2;
    grid_blocks = cus * per_cu;
    if (ws_size < OFF_END) fprintf(stderr, "kernel_launch: workspace too small: %zu < %zu\n", ws_size, (size_t)OFF_END);
  }
  Params p{};
  for (int i = 0; i < 19; ++i) p.in[i] = (const float*)d_in[i];
  p.out = (float*)d_out;
  p.ws = (unsigned char*)d_ws;
  void* args[] = {&p};
  hipError_t e = hipLaunchCooperativeKernel((const void*)fwd_megakernel, dim3(grid_blocks), dim3(256), args, LDS_BYTES, stream);
  if (e != hipSuccess) fprintf(stderr, "cooperative launch failed: %s (grid %d)\n", hipGetErrorString(e), grid_blocks);
}
```

```cpp
#include <hip/hip_runtime.h>
#include <hip/hip_cooperative_groups.h>
#include <cstdio>
#include <cstdint>
namespace cg = cooperative_groups;

typedef __attribute__((ext_vector_type(8))) short bf16x8;
typedef __attribute__((ext_vector_type(16))) float f32x16;
typedef __attribute__((ext_vector_type(4))) unsigned int u32x4;
typedef unsigned short u16;


#ifndef REP_GEMM
#define REP_GEMM 1
#endif
#ifndef REP_AD
#define REP_AD 1
#endif
#ifndef EXTRA_SYNC
#define EXTRA_SYNC 0
#endif
#ifndef REP_NSA
#define REP_NSA 1
#endif
#ifndef REP_F2
#define REP_F2 1
#endif
#ifndef REP_P0
#define REP_P0 1
#endif
#ifndef REP_F1
#define REP_F1 1
#endif
#ifndef REP_F3
#define REP_F3 1
#endif
#define DEV __device__ __forceinline__

#ifdef NO_GDNPREP
#define SK_GDNPREP(x)
#else
#define SK_GDNPREP(x) x
#endif
#ifdef NO_MLPREP
#define SK_MLPREP(x)
#else
#define SK_MLPREP(x) x
#endif
#ifdef NO_GDNSCAN
#define SK_GDNSCAN(x)
#else
#define SK_GDNSCAN(x) x
#endif
#ifdef NO_NSA
#define SK_NSA(x)
#else
#define SK_NSA(x) x
#endif
#ifdef NO_MLOUT
#define SK_MLOUT(x)
#else
#define SK_MLOUT(x) x
#endif
#ifdef NO_GDNOUT
#define SK_GDNOUT(x)
#else
#define SK_GDNOUT(x) x
#endif


static constexpr int T_ = 8192;
static constexpr int NT_ = 16384;
static constexpr int DM_ = 1024;
static constexpr int DFF_ = 2816;
static constexpr int PW_ = 3456;
static constexpr int INW_ = 3368;
static constexpr int LDS_BYTES = 75776;

static constexpr size_t OFF_HB   = 0;
static constexpr size_t OFF_WT   = 33554432;
static constexpr size_t OFF_MOD  = OFF_WT + 17301504;
static constexpr size_t OFF_B1   = OFF_MOD + 147456;
static constexpr size_t OFF_BAR  = OFF_MOD + 163840;
static constexpr size_t OFF_R    = OFF_MOD + 262144;
static constexpr size_t OFF_ACT  = OFF_R;
static constexpr size_t OFF_PROJ = OFF_R;
static constexpr size_t OFF_SIDE = OFF_PROJ + 113246208;
static constexpr size_t OFF_MLSV = OFF_SIDE + 2621440;
static constexpr size_t OFF_MLKV = OFF_MLSV + 16777216;
static constexpr size_t OFF_MLVEC= OFF_MLKV + 16777216;
static constexpr size_t OFF_GDM  = OFF_MLVEC + 1310720;
static constexpr size_t OFF_GDB  = OFF_GDM + 16777216;
static constexpr size_t OFF_GDQ  = OFF_GDB + 16777216;
static constexpr size_t OFF_GDP  = OFF_GDQ + 16777216;
static constexpr size_t OFF_QN   = OFF_GDP + 16777216;
static constexpr size_t OFF_KS   = OFF_QN + 16777216;
static constexpr size_t OFF_KW   = OFF_KS + 4194304;
static constexpr size_t OFF_VST  = OFF_KW + 4194304;
static constexpr size_t OFF_VWT  = OFF_VST + 4194304;
static constexpr size_t OFF_HID  = OFF_VWT + 4194304;
static constexpr size_t OFF_KC   = OFF_HID + 2097152;
static constexpr size_t OFF_VCT  = OFF_KC + 262144;
static constexpr size_t OFF_SPREV= OFF_VCT + 262144;
static constexpr size_t OFF_CPREV= OFF_SPREV + 16777216;
static constexpr size_t OFF_NPREV= OFF_CPREV + 16777216;
static constexpr size_t OFF_WTB  = OFF_NPREV + 262144;
static constexpr size_t OFF_WTC  = OFF_WTB + 11272192;
static constexpr size_t OFF_END  = OFF_WTC + 17301504;

static constexpr size_t WT_UP   = 0;
static constexpr size_t WT_DOWN = 11534336;
static constexpr size_t WT_IN   = 0;
static constexpr size_t WT_OUT  = 7077888;
static constexpr size_t WT_W1   = 7077888 + 2097152;

struct Params {
  const float* in[19];
  float* out;
  unsigned char* ws;
};

DEV u16 f2bf(float f) {
  uint32_t u = __float_as_uint(f);
  u += 0x7fffu + ((u >> 16) & 1u);
  return (u16)(u >> 16);
}
DEV int opaque_tid() { int t = threadIdx.x; asm volatile("" : "+v"(t)); return t; }
DEV float bf2f(u16 h) { return __uint_as_float(((uint32_t)h) << 16); }
DEV uint32_t cvtpk(float lo, float hi) { uint32_t r; asm("v_cvt_pk_bf16_f32 %0, %1, %2" : "=v"(r) : "v"(lo), "v"(hi)); return r; }
DEV uint32_t pack2(float a, float b) { return (uint32_t)f2bf(a) | ((uint32_t)f2bf(b) << 16); }
DEV float bflo(uint32_t w) { return __uint_as_float(w << 16); }
DEV float bfhi(uint32_t w) { return __uint_as_float(w & 0xffff0000u); }
DEV float sigmoidf_(float x) { return 1.f / (1.f + expf(-x)); }
DEV float siluf_(float x) { return x / (1.f + expf(-x)); }
DEV float wave_sum_lds(float v) {
#pragma unroll
  for (int o = 32; o >= 1; o >>= 1) v += __shfl_xor(v, o);
  return v;
}
DEV float wave_scan_add(float v, int lane) {
#pragma unroll
  for (int o = 1; o < 64; o <<= 1) { const float u = __shfl_up(v, o); if (lane >= o) v += u; }
  return v;
}
DEV float wave_scan_max(float v, int lane) {
#pragma unroll
  for (int o = 1; o < 64; o <<= 1) { const float u = __shfl_up(v, o); if (lane >= o) v = fmaxf(v, u); }
  return v;
}
DEV float dpp_f(float v, const int ctrl_sel) {
  const int iv = __float_as_int(v);
  int r;
  if (ctrl_sel == 0) r = __builtin_amdgcn_update_dpp(iv, iv, 0xB1, 0xF, 0xF, false);
  else if (ctrl_sel == 1) r = __builtin_amdgcn_update_dpp(iv, iv, 0x4E, 0xF, 0xF, false);
  else if (ctrl_sel == 2) r = __builtin_amdgcn_update_dpp(iv, iv, 0x124, 0xF, 0xF, false);
  else r = __builtin_amdgcn_update_dpp(iv, iv, 0x128, 0xF, 0xF, false);
  return __int_as_float(r);
}
DEV float wave_max_valu(float v) {
  typedef __attribute__((ext_vector_type(2))) unsigned u32x2_;
  v = fmaxf(v, dpp_f(v, 0));
  v = fmaxf(v, dpp_f(v, 1));
  v = fmaxf(v, dpp_f(v, 2));
  v = fmaxf(v, dpp_f(v, 3));
  const u32x2_ a = __builtin_amdgcn_permlane16_swap(__float_as_uint(v), __float_as_uint(v), false, false);
  v = fmaxf(__uint_as_float(a[0]), __uint_as_float(a[1]));
  const u32x2_ b = __builtin_amdgcn_permlane32_swap(__float_as_uint(v), __float_as_uint(v), false, false);
  return fmaxf(__uint_as_float(b[0]), __uint_as_float(b[1]));
}
DEV float wave_sum(float v) {
  typedef __attribute__((ext_vector_type(2))) unsigned u32x2_;
  v += dpp_f(v, 0);
  v += dpp_f(v, 1);
  v += dpp_f(v, 2);
  v += dpp_f(v, 3);
  const u32x2_ a = __builtin_amdgcn_permlane16_swap(__float_as_uint(v), __float_as_uint(v), false, false);
  v = __uint_as_float(a[0]) + __uint_as_float(a[1]);
  const u32x2_ b = __builtin_amdgcn_permlane32_swap(__float_as_uint(v), __float_as_uint(v), false, false);
  return __uint_as_float(b[0]) + __uint_as_float(b[1]);
}
DEV float row16_sum(float v) {
  v += dpp_f(v, 0);
  v += dpp_f(v, 1);
  v += dpp_f(v, 2);
  v += dpp_f(v, 3);
  return v;
}
DEV float wave_max(float v) {
#pragma unroll
  for (int o = 32; o >= 1; o >>= 1) v = fmaxf(v, __shfl_xor(v, o));
  return v;
}

DEV void job_mod(const Params& p, int job, float* sm) {
  const int tid = opaque_tid();
  float* mod = (float*)(p.ws + OFF_MOD);
  const int l = job / 144, cgp = job % 144;
  const int col = cgp * 64 + (tid & 63), kp = tid >> 6;
  const float* W = p.in[2] + (size_t)l * 1024 * 9216;
  const float* c = p.in[1];
  float a0 = 0.f, a1 = 0.f;
  float* cs = sm + 512;
  for (int i = tid; i < 2048; i += 256) cs[i] = siluf_(c[i]);
  __syncthreads();
#pragma unroll 16
  for (int k = kp * 256; k < kp * 256 + 256; ++k) {
    const float w = W[(size_t)k * 9216 + col];
    a0 += cs[k] * w; a1 += cs[1024 + k] * w;
  }
  sm[tid] = a0; sm[256 + tid] = a1;
  __syncthreads();
  if (tid < 64) {
    float bb = p.in[3][l * 9216 + col];
    mod[(l * 2 + 0) * 9216 + col] = sm[tid] + sm[tid + 64] + sm[tid + 128] + sm[tid + 192] + bb;
    mod[(l * 2 + 1) * 9216 + col] = sm[256 + tid] + sm[256 + tid + 64] + sm[256 + tid + 128] + sm[256 + tid + 192] + bb;
  }
  __syncthreads();
}

DEV void job_bias1(const Params& p, int job, float* sm) {
  const int tid = opaque_tid();
  float* b1 = (float*)(p.ws + OFF_B1);
  const int lk = job >> 2, cgp = job & 3;
  const int col = cgp * 64 + (tid & 63), kp = tid >> 6;
  const float* W = p.in[17] + (size_t)lk * 2048 * 256;
  const float* pos = p.in[16] + (size_t)lk * 2048;
  float a = 0.f;
#pragma unroll 32
  for (int j = kp * 512; j < kp * 512 + 512; ++j) a += pos[j] * W[(size_t)j * 256 + col];
  sm[tid] = a;
  __syncthreads();
  if (tid < 64) b1[lk * 256 + col] = sm[tid] + sm[tid + 64] + sm[tid + 128] + sm[tid + 192];
  __syncthreads();
}

DEV void job_wt(const float* __restrict__ src, int ldsrc, u16* __restrict__ dst, int Kdst, int k0, int r0, int mode, int nvalid, float* sm) {
  const int tid = opaque_tid();
  const int rr = tid & 63, kk0 = tid >> 6;
  int scol; bool ok = true;
  if (mode == 1) {
    const int nb = r0 >> 7, wn = (r0 >> 6) & 1, s = rr >> 5, cc = rr & 31;
    scol = s * 2816 + 64 * nb + 32 * wn + cc;
  } else { scol = r0 + rr; ok = scol < nvalid; if (!ok) scol = 0; }
#pragma unroll
  for (int i = 0; i < 16; ++i) {
    const int kk = kk0 + 4 * i;
    float v = src[(size_t)(k0 + kk) * ldsrc + scol];
    sm[kk * 65 + rr] = ok ? v : 0.f;
  }
  __syncthreads();
  const int r = tid >> 2, kq = tid & 3;
  uint32_t w[8];
#pragma unroll
  for (int i = 0; i < 8; ++i) w[i] = pack2(sm[(kq * 16 + 2 * i) * 65 + r], sm[(kq * 16 + 2 * i + 1) * 65 + r]);
  uint4* d = (uint4*)(dst + (size_t)(r0 + r) * Kdst + k0 + kq * 16);
  d[0] = make_uint4(w[0], w[1], w[2], w[3]);
  d[1] = make_uint4(w[4], w[5], w[6], w[7]);
  __syncthreads();
}

DEV void job_adaln(const float* __restrict__ x, const float* __restrict__ nw, const float* __restrict__ modl, int sub, u16* __restrict__ hb, int job) {
  const int tid = opaque_tid(), lane = tid & 63, wave = tid >> 6;
  const int row = job * 4 + wave;
  const int b = row >> 13;
  const float* shift = modl + b * 9216 + (3 * sub) * 1024;
  const float* scale = shift + 1024;
  const float4* xr = (const float4*)(x + (size_t)row * 1024);
  float4 v[4]; float ss = 0.f;
#pragma unroll
  for (int i = 0; i < 4; ++i) { v[i] = xr[lane + 64 * i]; ss += v[i].x * v[i].x + v[i].y * v[i].y + v[i].z * v[i].z + v[i].w * v[i].w; }
  float4 n4v[4], scv[4], shv[4];
#pragma unroll
  for (int i = 0; i < 4; ++i) {
    const int k = (lane + 64 * i) * 4;
    n4v[i] = *(const float4*)(nw + k); scv[i] = *(const float4*)(scale + k); shv[i] = *(const float4*)(shift + k);
  }
  __builtin_amdgcn_sched_barrier(0);
  ss = wave_sum(ss);
  const float rstd = rsqrtf(ss * (1.f / 1024.f) + 1e-6f);
#pragma unroll
  for (int i = 0; i < 4; ++i) {
    const int k = (lane + 64 * i) * 4;
    const float4 n4 = n4v[i], sc = scv[i], sh = shv[i];
    float y0 = v[i].x * rstd * n4.x * (1.f + sc.x) + sh.x;
    float y1 = v[i].y * rstd * n4.y * (1.f + sc.y) + sh.y;
    float y2 = v[i].z * rstd * n4.z * (1.f + sc.z) + sh.z;
    float y3 = v[i].w * rstd * n4.w * (1.f + sc.w) + sh.w;
    *(uint2*)(hb + (size_t)row * 1024 + k) = make_uint2(pack2(y0, y1), pack2(y2, y3));
  }
}

struct ALplain {
  const u16* A; int lda;
  DEV const u16* ptr(int row, int k) const { return A + (size_t)row * lda + k; }
};
struct ALcmp {
  const u16* pb;
  DEV const u16* ptr(int row, int k) const {
    int tok = 16 * row + (k >> 6); tok = tok > (T_ - 1) ? (T_ - 1) : tok;
    return pb + (size_t)tok * PW_ + (k & 63);
  }
};

template <class AL, class EPI>
DEV void gemm_tile(unsigned char* smem, const AL& al, const u16* __restrict__ Bt, int ldb, int nk, const EPI& epi, int m0, int n0) {
  const int tid = opaque_tid(), lane = tid & 63, wave = tid >> 6;
  const int wm = wave >> 1, wn = wave & 1;
  const int r = lane & 31, h = lane >> 5;
  unsigned char* lds = smem;
  const int lr = lane >> 3, lp = lane & 7;
  const int sw = (r >> 1) & 7;
  f32x16 acc[2][2];
#pragma unroll
  for (int a = 0; a < 2; ++a)
#pragma unroll
    for (int b = 0; b < 2; ++b)
#pragma unroll
      for (int i = 0; i < 16; ++i) acc[a][b][i] = 0.f;
#define DMA_A(i_, kt_, buf_)                                                             \
  {                                                                                      \
    const int row_ = ((i_) * 4 + wave) * 8 + lr;                                         \
    const int c_ = lp ^ ((row_ >> 1) & 7);                                               \
    __builtin_amdgcn_global_load_lds((const unsigned*)al.ptr(m0 + row_, (kt_) * 64 + c_ * 8),                                  \
                                     (unsigned*)(lds + (buf_) * 32768 + ((i_) * 4 + wave) * 1024 + lane * 16), 16, 0, 0);      \
  }
#define DMA_B(i_, kt_, buf_)                                                             \
  {                                                                                      \
    const int row_ = ((i_) * 4 + wave) * 8 + lr;                                         \
    const int c_ = lp ^ ((row_ >> 1) & 7);                                               \
    __builtin_amdgcn_global_load_lds((const unsigned*)(Bt + (size_t)(n0 + row_) * ldb + (kt_) * 64 + c_ * 8),                  \
                                     (unsigned*)(lds + (buf_) * 32768 + 16384 + ((i_) * 4 + wave) * 1024 + lane * 16), 16, 0, 0); \
  }
#define MMA4(buf_, ks_)                                                                  \
  {                                                                                      \
    bf16x8 a[2], b[2];                                                                   \
    const int p_ = ((2 * (ks_) + h) ^ sw) * 16;                                          \
    _Pragma("unroll") for (int mt = 0; mt < 2; ++mt) a[mt] = *(const bf16x8*)(lds + (buf_) * 32768 + (wm * 64 + mt * 32 + r) * 128 + p_);          \
    _Pragma("unroll") for (int nt = 0; nt < 2; ++nt) b[nt] = *(const bf16x8*)(lds + (buf_) * 32768 + 16384 + (wn * 64 + nt * 32 + r) * 128 + p_);  \
    _Pragma("unroll") for (int mt = 0; mt < 2; ++mt)                                     \
      _Pragma("unroll") for (int nt = 0; nt < 2; ++nt) acc[mt][nt] = __builtin_amdgcn_mfma_f32_32x32x16_bf16(a[mt], b[nt], acc[mt][nt], 0, 0, 0); \
  }
#define DMA_WAIT_BARRIER()                                                               \
  {                                                                                      \
    asm volatile("s_waitcnt vmcnt(0)" ::: "memory");                                     \
    __builtin_amdgcn_s_barrier();                                                        \
    asm volatile("" ::: "memory");                                                       \
  }
  DMA_A(0, 0, 0); DMA_A(1, 0, 0); DMA_A(2, 0, 0); DMA_A(3, 0, 0);
  DMA_B(0, 0, 0); DMA_B(1, 0, 0); DMA_B(2, 0, 0); DMA_B(3, 0, 0);
  DMA_WAIT_BARRIER();
  for (int kt = 0; kt < nk - 1; ++kt) {
    const int buf = kt & 1, nbuf = buf ^ 1;
    DMA_A(0, kt + 1, nbuf); DMA_A(1, kt + 1, nbuf); DMA_B(0, kt + 1, nbuf); DMA_B(1, kt + 1, nbuf);
    MMA4(buf, 0);
    DMA_A(2, kt + 1, nbuf); DMA_A(3, kt + 1, nbuf); DMA_B(2, kt + 1, nbuf); DMA_B(3, kt + 1, nbuf);
    MMA4(buf, 1);
    MMA4(buf, 2);
    MMA4(buf, 3);
    DMA_WAIT_BARRIER();
  }
  typename EPI::State est;
  epi.pre(est, m0 + wm * 64, n0 + wn * 64, r, h);
  __builtin_amdgcn_sched_barrier(0);
  MMA4(1, 0);
  MMA4(1, 1);
  MMA4(1, 2);
  MMA4(1, 3);
  DMA_WAIT_BARRIER();
#undef DMA_A
#undef DMA_B
#undef MMA4
#undef DMA_WAIT_BARRIER
  epi(acc, est, m0 + wm * 64, n0 + wn * 64, r, h);
}

struct EpiUp {
  u16* act;
  struct State {};
  DEV void pre(State&, int, int, int, int) const {}
  DEV void operator()(f32x16 (&acc)[2][2], State&, int mb, int nb, int r, int h) const {
    const int col = (nb >> 1) + r;
#pragma unroll
    for (int mt = 0; mt < 2; ++mt)
#pragma unroll
      for (int i = 0; i < 16; ++i) {
        const int m = mb + mt * 32 + (i & 3) + 8 * (i >> 2) + 4 * h;
        const float g = acc[mt][0][i], u = acc[mt][1][i];
        act[(size_t)m * DFF_ + col] = f2bf(g / (1.f + __expf(-g)) * u);
      }
  }
};
struct EpiRes {
  const float* src; float* dst; const float* gate; float coef;
  struct State { float sv[2][2][16]; float gg[2]; };
  DEV void pre(State& st, int mb, int nb, int r, int h) const {
#pragma unroll
    for (int nt = 0; nt < 2; ++nt) st.gg[nt] = gate[(mb >> 13) * 9216 + nb + nt * 32 + r] * coef;
#pragma unroll
    for (int mt = 0; mt < 2; ++mt)
#pragma unroll
      for (int nt = 0; nt < 2; ++nt)
#pragma unroll
        for (int i = 0; i < 16; ++i) {
          const int m = mb + mt * 32 + (i & 3) + 8 * (i >> 2) + 4 * h;
          st.sv[mt][nt][i] = src[(size_t)m * 1024 + nb + nt * 32 + r];
        }
  }
  DEV void operator()(f32x16 (&acc)[2][2], State& st, int mb, int nb, int r, int h) const {
#pragma unroll
    for (int mt = 0; mt < 2; ++mt)
#pragma unroll
      for (int nt = 0; nt < 2; ++nt)
#pragma unroll
        for (int i = 0; i < 16; ++i) {
          const int m = mb + mt * 32 + (i & 3) + 8 * (i >> 2) + 4 * h;
          dst[(size_t)m * 1024 + nb + nt * 32 + r] = st.sv[mt][nt][i] + st.gg[nt] * acc[mt][nt][i];
        }
  }
};
struct EpiIn {
  u16* proj; float* side;
  struct State {};
  DEV void pre(State&, int, int, int, int) const {}
  DEV void operator()(f32x16 (&acc)[2][2], State&, int mb, int nb, int r, int h) const {
#pragma unroll
    for (int mt = 0; mt < 2; ++mt)
#pragma unroll
      for (int nt = 0; nt < 2; ++nt) {
        const int n = nb + nt * 32 + r;
        int sidx = -1;
        if (n >= 1024 && n < 1032) sidx = n - 1024;
        else if (n >= 2056 && n < 2064) sidx = 8 + n - 2056;
        else if (n >= 3344 && n < 3368) sidx = 16 + n - 3344;
#pragma unroll
        for (int i = 0; i < 16; ++i) {
          const int m = mb + mt * 32 + (i & 3) + 8 * (i >> 2) + 4 * h;
          proj[(size_t)m * PW_ + n] = f2bf(acc[mt][nt][i]);
          if (sidx >= 0) side[(size_t)m * 40 + sidx] = acc[mt][nt][i];
        }
      }
  }
};
struct EpiHid {
  u16* hid; const float* bias;
  struct State {};
  DEV void pre(State&, int, int, int, int) const {}
  DEV void operator()(f32x16 (&acc)[2][2], State&, int mb, int nb, int r, int h) const {
#pragma unroll
    for (int mt = 0; mt < 2; ++mt)
#pragma unroll
      for (int nt = 0; nt < 2; ++nt) {
        const int n = nb + nt * 32 + r;
        const float bb = bias[n];
#pragma unroll
        for (int i = 0; i < 16; ++i) {
          const int m = mb + mt * 32 + (i & 3) + 8 * (i >> 2) + 4 * h;
          hid[(size_t)m * 256 + n] = f2bf(siluf_(acc[mt][nt][i] + bb));
        }
      }
  }
};

template <bool TA, bool TB>
DEV void mm64(const float* A, const float* B, float (&acc)[4][4], int ti, int tj) {
#pragma unroll 4
  for (int k = 0; k < 64; ++k) {
    float a[4], b[4];
#pragma unroll
    for (int ii = 0; ii < 4; ++ii) a[ii] = TA ? A[k * 65 + ti + 16 * ii] : A[(ti + 16 * ii) * 65 + k];
#pragma unroll
    for (int jj = 0; jj < 4; ++jj) b[jj] = TB ? B[(tj + 16 * jj) * 65 + k] : B[k * 65 + tj + 16 * jj];
#pragma unroll
    for (int ii = 0; ii < 4; ++ii)
#pragma unroll
      for (int jj = 0; jj < 4; ++jj) acc[ii][jj] += a[ii] * b[jj];
  }
}
#define ZERO44(a_) { _Pragma("unroll") for (int ii = 0; ii < 4; ++ii) _Pragma("unroll") for (int jj = 0; jj < 4; ++jj) a_[ii][jj] = 0.f; }

template <bool TA, bool TB>
DEV void mm64m(const float* A, const float* B, f32x16& acc, int i0, int j0, int lane) {
  const int r = lane & 31, kh = lane >> 5;
#pragma unroll 8
  for (int k = 0; k < 64; k += 2) {
    const float a = TA ? A[(k + kh) * 65 + i0 + r] : A[(i0 + r) * 65 + k + kh];
    const float b = TB ? B[(j0 + r) * 65 + k + kh] : B[(k + kh) * 65 + j0 + r];
    acc = __builtin_amdgcn_mfma_f32_32x32x2f32(a, b, acc, 0, 0, 0);
  }
}
#define ZERO16(a_) { _Pragma("unroll") for (int q = 0; q < 16; ++q) a_[q] = 0.f; }
#define QROW(q_) (rb + ((q_) & 3) + 8 * ((q_) >> 2))

DEV void load_blk(const u16* __restrict__ src, float* dst, float scale) {
  const int tid = opaque_tid(), r = tid >> 2, seg = tid & 3;
  const uint4* s = (const uint4*)(src + (size_t)r * PW_ + seg * 16);
  uint4 a = s[0], b = s[1];
  uint32_t w[8] = {a.x, a.y, a.z, a.w, b.x, b.y, b.z, b.w};
#pragma unroll
  for (int i = 0; i < 8; ++i) {
    dst[r * 65 + seg * 16 + 2 * i] = bflo(w[i]) * scale;
    dst[r * 65 + seg * 16 + 2 * i + 1] = bfhi(w[i]) * scale;
  }
}

DEV void job_ml_prep(const Params& p, int l, int job, float* sm) {
  const int tid = opaque_tid(), lane = tid & 63, wave = tid >> 6;
  const int i0 = (wave >> 1) * 32, j0 = (wave & 1) * 32, rb = i0 + 4 * (lane >> 5), cc = j0 + (lane & 31);
  const int c = job & 127, bh = job >> 7, b = bh >> 2, h = bh & 3;
  const int t0 = c * 64;
  const u16* proj = (const u16*)(p.ws + OFF_PROJ);
  const float* side = (const float*)(p.ws + OFF_SIDE);
  float* Qs = sm, *Ks = sm + 4160, *Vs = sm + 8320, *Ss = sm + 12480;
  float* vec = sm + 16640;
  float* li = vec, *lf = vec + 64, *cum = vec + 128, *dmx = vec + 192, *wgt = vec + 256, *misc = vec + 320;
  const size_t tokb = (size_t)b * T_ + t0;
  load_blk(proj + tokb * PW_ + 0 + h * 64, Qs, 0.125f);
  load_blk(proj + tokb * PW_ + 256 + h * 64, Ks, 1.f);
  load_blk(proj + tokb * PW_ + 512 + h * 64, Vs, 1.f);
  if (tid < 64) {
    const float* sd = side + (tokb + tid) * 40;
    const float* gb = p.in[9] + l * 8;
    li[tid] = sd[h] + gb[h];
    const float xf = sd[4 + h] + gb[4 + h];
    lf[tid] = fminf(xf, 0.f) - log1pf(expf(-fabsf(xf)));
  }
  if (tid < 64) {
    const float run = wave_scan_add(lf[tid], tid);
    const float pm = wave_scan_max(li[tid] - run, tid);
    cum[tid] = run; dmx[tid] = run + pm;
    if (tid == 63) misc[1] = run;
  }
  __syncthreads();
  const float gtot = misc[1];
  if (tid < 64) {
    const float a = gtot - cum[tid] + li[tid];
    const float ml = wave_max(a);
    wgt[tid] = expf(a - ml);
    if (tid == 0) misc[0] = ml;
  }
  f32x16 acc;
  ZERO16(acc);
  mm64m<false, true>(Qs, Ks, acc, i0, j0, lane);
#pragma unroll
  for (int q = 0; q < 16; ++q) {
    const int t = QROW(q), j = cc;
    Ss[t * 65 + j] = (j <= t) ? acc[q] * expf(cum[t] - cum[j] + li[j] - dmx[t]) : 0.f;
  }
  __syncthreads();
  float* sv = (float*)(p.ws + OFF_MLSV) + (size_t)job * 4096;
  float* kv = (float*)(p.ws + OFF_MLKV) + (size_t)job * 4096;
  float* vo = (float*)(p.ws + OFF_MLVEC) + (size_t)job * 320;
  ZERO16(acc);
  mm64m<false, false>(Ss, Vs, acc, i0, j0, lane);
#pragma unroll
  for (int q = 0; q < 16; ++q) sv[QROW(q) * 64 + cc] = acc[q];
  if (tid < 64) {
    float s = 0.f;
    for (int j = 0; j < 64; ++j) s += Ss[tid * 65 + j];
    vo[0 * 64 + tid] = s; vo[1 * 64 + tid] = dmx[tid]; vo[2 * 64 + tid] = cum[tid];
    if (tid == 0) { vo[4 * 64 + 0] = misc[0]; vo[4 * 64 + 1] = gtot; }
  }
  for (int idx = tid; idx < 4096; idx += 256) { const int j = idx >> 6, d = idx & 63; Ks[j * 65 + d] *= wgt[j]; }
  __syncthreads();
  ZERO16(acc);
  mm64m<true, false>(Ks, Vs, acc, i0, j0, lane);
#pragma unroll
  for (int q = 0; q < 16; ++q) kv[QROW(q) * 64 + cc] = acc[q];
  if (tid < 64) {
    float s = 0.f;
    for (int j = 0; j < 64; ++j) s += Ks[j * 65 + tid];
    vo[3 * 64 + tid] = s;
  }
  __syncthreads();
}

DEV void job_ml_scan(const Params& p, int job) {
  __builtin_amdgcn_s_setprio(3);
  const int tid = opaque_tid();
  const int bh = job / 17, part = job % 17;
  const float* __restrict__ kvb = (const float*)(p.ws + OFF_MLKV) + (size_t)bh * 128 * 4096;
  float* __restrict__ cpb = (float*)(p.ws + OFF_CPREV) + (size_t)bh * 128 * 4096;
  float* __restrict__ npb = (float*)(p.ws + OFF_NPREV) + (size_t)bh * 128 * 64;
  float* vob = (float*)(p.ws + OFF_MLVEC) + (size_t)bh * 128 * 320;
  float m = 0.f, C = 0.f;
  const int idx = part * 256 + tid;
#pragma unroll 8
  for (int c = 0; c < 128; ++c) {
    float* vo = vob + c * 320;
    const float gt = vo[4 * 64 + 1], ml = vo[4 * 64 + 0];
    const float mn = fmaxf(gt + m, ml);
    const float so = expf(gt + m - mn), sn = expf(ml - mn);
    if (part < 16) {
      const float kvv = kvb[(size_t)c * 4096 + idx];
      cpb[(size_t)c * 4096 + idx] = C;
      C = so * C + sn * kvv;
    } else {
      if (tid < 64) { const float nl = vo[3 * 64 + tid]; npb[c * 64 + tid] = C; C = so * C + sn * nl; }
      else if (tid == 64) vo[4 * 64 + 2] = m;
    }
    m = mn;
  }
  __builtin_amdgcn_s_setprio(0);
}

DEV void job_ml_out(const Params& p, int l, int job, float* sm) {
  const int tid = opaque_tid(), ti = tid >> 4, tj = tid & 15;
  const int c = job & 127, bh = job >> 7, b = bh >> 2, h = bh & 3;
  const int t0 = c * 64;
  const u16* proj = (const u16*)(p.ws + OFF_PROJ);
  u16* y = (u16*)(p.ws + OFF_HB);
  float* Qs = sm, *Cs = sm + 4160;
  float* vec = sm + 16640;
  float* rr = vec, *it = vec + 64;
  const size_t tokb = (size_t)b * T_ + t0;
  const float* sv = (const float*)(p.ws + OFF_MLSV) + (size_t)job * 4096;
  const float* cp = (const float*)(p.ws + OFF_CPREV) + (size_t)job * 4096;
  const float* npv = (const float*)(p.ws + OFF_NPREV) + (size_t)job * 64;
  const float* vo = (const float*)(p.ws + OFF_MLVEC) + (size_t)job * 320;
  load_blk(proj + tokb * PW_ + 0 + h * 64, Qs, 0.125f);
  for (int idx = tid; idx < 4096; idx += 256) Cs[(idx >> 6) * 65 + (idx & 63)] = cp[idx];
  const float* nw = p.in[10] + l * 64;
  float svv[4][4], ogv[4][4], nwv[4];
#pragma unroll
  for (int jj = 0; jj < 4; ++jj) nwv[jj] = nw[tj + 16 * jj];
#pragma unroll
  for (int ii = 0; ii < 4; ++ii)
#pragma unroll
    for (int jj = 0; jj < 4; ++jj) {
      const int t = ti + 16 * ii, e = tj + 16 * jj;
      svv[ii][jj] = sv[t * 64 + e];
      ogv[ii][jj] = bf2f(proj[(tokb + t) * PW_ + 768 + h * 64 + e]);
    }
  __builtin_amdgcn_sched_barrier(0);
  __syncthreads();
  if (tid < 64) {
    float qn = 0.f;
    for (int d = 0; d < 64; ++d) qn += Qs[tid * 65 + d] * npv[d];
    const float mprev = vo[4 * 64 + 2];
    const float cumt = vo[2 * 64 + tid], dmax = vo[1 * 64 + tid], ssum = vo[0 * 64 + tid];
    const float minter = cumt + mprev;
    const float mt = fmaxf(minter, dmax);
    const float r = expf(dmax - mt), inter = expf(minter - mt);
    float den = r * ssum + inter * qn;
    den = fmaxf(fabsf(den), expf(-mt));
    rr[tid] = r / den; it[tid] = inter / den;
  }
  float acc[4][4];
  {
    const int lane_ = tid & 63, wave_ = tid >> 6;
    const int i0 = (wave_ >> 1) * 32, j0 = (wave_ & 1) * 32, rb = i0 + 4 * (lane_ >> 5), cc = j0 + (lane_ & 31);
    float* Hs = sm + 8320;
    f32x16 am;
    ZERO16(am);
    mm64m<false, false>(Qs, Cs, am, i0, j0, lane_);
#pragma unroll
    for (int q = 0; q < 16; ++q) Hs[QROW(q) * 65 + cc] = am[q];
    __syncthreads();
#pragma unroll
    for (int ii = 0; ii < 4; ++ii)
#pragma unroll
      for (int jj = 0; jj < 4; ++jj) acc[ii][jj] = Hs[(ti + 16 * ii) * 65 + tj + 16 * jj];
  }
#pragma unroll
  for (int ii = 0; ii < 4; ++ii) {
    const int t = ti + 16 * ii;
    float hv[4]; float ss = 0.f;
#pragma unroll
    for (int jj = 0; jj < 4; ++jj) { hv[jj] = rr[t] * svv[ii][jj] + it[t] * acc[ii][jj]; ss += hv[jj] * hv[jj]; }
    ss = row16_sum(ss);
    const float rs = rsqrtf(ss * (1.f / 64.f) + 1e-6f);
#pragma unroll
    for (int jj = 0; jj < 4; ++jj) {
      const int e = tj + 16 * jj;
      y[(tokb + t) * 1024 + h * 64 + e] = f2bf(sigmoidf_(ogv[ii][jj]) * hv[jj] * rs * nwv[jj]);
    }
  }
  __syncthreads();
}

DEV void gdn_load_conv(const u16* __restrict__ proj, const float* __restrict__ cw, int b, int t0, int h, int which, float* dst, float post, bool l2n) {
  const int tid = opaque_tid(), r = tid >> 2, seg = tid & 3;
  const int ch0 = which * 256 + h * 64 + seg * 16;
  float a[16];
#pragma unroll
  for (int e = 0; e < 16; ++e) a[e] = 0.f;
#pragma unroll
  for (int kk = 0; kk < 4; ++kk) {
    const int tt = t0 + r - 3 + kk;
    if (tt >= 0) {
      const uint4* s = (const uint4*)(proj + ((size_t)b * T_ + tt) * PW_ + 1032 + ch0);
      uint4 u0 = s[0], u1 = s[1];
      uint32_t w[8] = {u0.x, u0.y, u0.z, u0.w, u1.x, u1.y, u1.z, u1.w};
      const float* cwk = cw + kk * 768 + ch0;
#pragma unroll
      for (int i = 0; i < 8; ++i) { a[2 * i] += cwk[2 * i] * bflo(w[i]); a[2 * i + 1] += cwk[2 * i + 1] * bfhi(w[i]); }
    }
  }
  float ss = 0.f;
#pragma unroll
  for (int e = 0; e < 16; ++e) { a[e] = siluf_(a[e]); ss += a[e] * a[e]; }
  float sc = post;
  if (l2n) { ss += __shfl_xor(ss, 1); ss += __shfl_xor(ss, 2); sc = rsqrtf(ss + 1e-6f) * post; }
#pragma unroll
  for (int e = 0; e < 16; ++e) dst[r * 65 + seg * 16 + e] = a[e] * sc;
}

DEV void job_gdn_prep(const Params& p, int l, int job, float* sm) {
  const int tid = opaque_tid(), lane = tid & 63, wave = tid >> 6;
  const int i0 = (wave >> 1) * 32, j0 = (wave & 1) * 32, rb = i0 + 4 * (lane >> 5), cc = j0 + (lane & 31);
  const int c = job & 127, bh = job >> 7, b = bh >> 2, h = bh & 3;
  const int t0 = c * 64;
  const u16* proj = (const u16*)(p.ws + OFF_PROJ);
  const float* side = (const float*)(p.ws + OFF_SIDE);
  const float* cw = p.in[11] + l * 4 * 768;
  float* B1 = sm, *B2 = sm + 4160, *B3 = sm + 8320, *B4 = sm + 12480;
  float* vec = sm + 16640;
  float* bet = vec, *gam = vec + 64, *eg = vec + 128;
  gdn_load_conv(proj, cw, b, t0, h, 1, B1, 1.f, true);
  gdn_load_conv(proj, cw, b, t0, h, 2, B2, 1.f, false);
  if (tid < 64) {
    const float* sd = side + ((size_t)b * T_ + t0 + tid) * 40;
    bet[tid] = sigmoidf_(sd[12 + h]);
    const float x = sd[8 + h] + p.in[13][l * 4 + h];
    const float sp = x > 20.f ? x : log1pf(expf(x));
    const float g = wave_scan_add(-expf(p.in[12][l * 4 + h]) * sp, tid);
    gam[tid] = g; eg[tid] = expf(g);
  }
  __syncthreads();
  f32x16 acc;
  ZERO16(acc);
  mm64m<false, true>(B1, B1, acc, i0, j0, lane);
#pragma unroll
  for (int q = 0; q < 16; ++q) {
    const int t = QROW(q), j = cc;
    B3[t * 65 + j] = (t > j) ? bet[t] * acc[q] * expf(gam[t] - gam[j]) : 0.f;
  }
  __syncthreads();
  if (tid < 128) {
    const bool isU = tid < 64; const int cc = tid & 63;
    float* X = isU ? B2 : B4;
    if (isU) { for (int t = 0; t < 64; ++t) X[t * 65 + cc] *= bet[t]; }
    else { for (int t = 0; t < 64; ++t) X[t * 65 + cc] = bet[t] * eg[t] * B1[t * 65 + cc]; }
    for (int tb = 0; tb < 64; tb += 8) {
      float rr[8];
#pragma unroll
      for (int u = 0; u < 8; ++u) rr[u] = X[(tb + u) * 65 + cc];
#pragma unroll 4
      for (int j = 0; j < tb; ++j) {
        const float xj = X[j * 65 + cc];
#pragma unroll
        for (int u = 0; u < 8; ++u) rr[u] -= B3[(tb + u) * 65 + j] * xj;
      }
#pragma unroll
      for (int u = 1; u < 8; ++u)
#pragma unroll
        for (int v = 0; v < u; ++v) rr[u] -= B3[(tb + u) * 65 + tb + v] * rr[v];
#pragma unroll
      for (int u = 0; u < 8; ++u) X[(tb + u) * 65 + cc] = rr[u];
    }
  }
  __syncthreads();
  gdn_load_conv(proj, cw, b, t0, h, 0, B3, 0.125f, true);
  __syncthreads();
  f32x16 P;
  ZERO16(P);
  mm64m<false, true>(B3, B1, P, i0, j0, lane);
#pragma unroll
  for (int q = 0; q < 16; ++q) {
    const int t = QROW(q), j = cc;
    P[q] = (t >= j) ? P[q] * expf(gam[t] - gam[j]) : 0.f;
  }
  __syncthreads();
  const float g63 = gam[63];
  for (int idx = tid; idx < 4096; idx += 256) { const int ll = idx >> 6, d = idx & 63; B1[ll * 65 + d] *= expf(g63 - gam[ll]); }
  __syncthreads();
  const float gl = eg[63];
  float* Mo = (float*)(p.ws + OFF_GDM) + (size_t)job * 4096;
  float* Bo = (float*)(p.ws + OFF_GDB) + (size_t)job * 4096;
  float* Qo = (float*)(p.ws + OFF_GDQ) + (size_t)job * 4096;
  float* Po = (float*)(p.ws + OFF_GDP) + (size_t)job * 4096;
  ZERO16(acc);
  mm64m<true, false>(B1, B4, acc, i0, j0, lane);
#pragma unroll
  for (int q = 0; q < 16; ++q) { const int d = QROW(q), d2 = cc; Mo[d * 64 + d2] = (d == d2 ? gl : 0.f) - acc[q]; }
  ZERO16(acc);
  mm64m<true, false>(B1, B2, acc, i0, j0, lane);
#pragma unroll
  for (int q = 0; q < 16; ++q) Bo[QROW(q) * 64 + cc] = acc[q];
  __syncthreads();
#pragma unroll
  for (int q = 0; q < 16; ++q) B1[QROW(q) * 65 + cc] = P[q];
  __syncthreads();
  ZERO16(acc);
  mm64m<false, false>(B1, B4, acc, i0, j0, lane);
#pragma unroll
  for (int q = 0; q < 16; ++q) { const int t = QROW(q), d = cc; Qo[t * 64 + d] = B3[t * 65 + d] * eg[t] - acc[q]; }
  ZERO16(acc);
  mm64m<false, false>(B1, B2, acc, i0, j0, lane);
#pragma unroll
  for (int q = 0; q < 16; ++q) Po[QROW(q) * 64 + cc] = acc[q];
  __syncthreads();
}

DEV void job_gdn_scan(const Params& p, int job, float* sm) {
  __builtin_amdgcn_s_setprio(3);
  const int tid = opaque_tid(), d = tid >> 2, e = tid & 3;
  const int bh = job >> 4, slice = job & 15, col = slice * 4 + e;
  const float* Mb = (const float*)(p.ws + OFF_GDM) + (size_t)bh * 128 * 4096;
  const float* Bb = (const float*)(p.ws + OFF_GDB) + (size_t)bh * 128 * 4096 + d * 64 + col;
  float* Sb = (float*)(p.ws + OFF_SPREV) + (size_t)bh * 128 * 4096 + d * 64 + col;
  float* Ml = sm;
  float* Sl = sm + 8704;
  const int lrow = tid >> 4, lc4 = (tid & 15) * 4;
  float S = 0.f;
  float4 a0, a1, a2, a3, b0, b1, b2, b3;
  float bvA, bvB;
#define LOADM(c_, A, B, C, D) { const float4* mp = (const float4*)(Mb + (size_t)(c_) * 4096); A = mp[tid]; B = mp[tid + 256]; C = mp[tid + 512]; D = mp[tid + 768]; }
#define STOREM(st_, A, B, C, D) { float* ml = Ml + (st_) * 4352 + lrow * 68 + lc4; *(float4*)ml = A; *(float4*)(ml + 16 * 68) = B; *(float4*)(ml + 32 * 68) = C; *(float4*)(ml + 48 * 68) = D; }
#define GSTEP(c_, A, B, C, D, BV)                                                        \
  {                                                                                      \
    float* sl = Sl + ((c_) & 1) * 272;                                                   \
    sl[e * 68 + d] = S;                                                                  \
    const float bcur = BV;                                                               \
    Sb[(size_t)(c_) * 4096] = S;                                                         \
    __syncthreads();                                                                     \
    if ((c_) + 1 < 128) STOREM(((c_) + 1) & 1, A, B, C, D);                              \
    if ((c_) + 3 < 128) LOADM((c_) + 3, A, B, C, D);                                     \
    if ((c_) + 2 < 128) BV = Bb[(size_t)((c_) + 2) * 4096];                              \
    __builtin_amdgcn_sched_barrier(0);                                                   \
    const float* mlc = Ml + ((c_) & 1) * 4352 + d * 68;                                  \
    float acc_ = bcur;                                                                   \
    _Pragma("unroll") for (int i = 0; i < 16; ++i) {                                     \
      const float4 m4 = *(const float4*)(mlc + 4 * i);                                   \
      const float4 s4 = *(const float4*)(sl + e * 68 + 4 * i);                           \
      acc_ += m4.x * s4.x + m4.y * s4.y + m4.z * s4.z + m4.w * s4.w;                     \
    }                                                                                    \
    S = acc_;                                                                            \
  }
  LOADM(0, a0, a1, a2, a3);
  STOREM(0, a0, a1, a2, a3);
  LOADM(1, a0, a1, a2, a3);
  LOADM(2, b0, b1, b2, b3);
  bvA = Bb[0]; bvB = Bb[4096];
  for (int c = 0; c < 128; c += 2) {
    GSTEP(c, a0, a1, a2, a3, bvA);
    GSTEP(c + 1, b0, b1, b2, b3, bvB);
  }
#undef LOADM
#undef STOREM
#undef GSTEP
  __builtin_amdgcn_s_setprio(0);
  __syncthreads();
}

DEV void job_gdn_out(const Params& p, int l, int job, float* sm) {
  const int tid = opaque_tid(), ti = tid >> 4, tj = tid & 15;
  const int c = job & 127, bh = job >> 7, b = bh >> 2, h = bh & 3;
  const int t0 = c * 64;
  const u16* proj = (const u16*)(p.ws + OFF_PROJ);
  u16* y = (u16*)(p.ws + OFF_HB);
  float* B1 = sm, *B2 = sm + 4160;
  const float* Qo = (const float*)(p.ws + OFF_GDQ) + (size_t)job * 4096;
  const float* So = (const float*)(p.ws + OFF_SPREV) + (size_t)job * 4096;
  const float* Po = (const float*)(p.ws + OFF_GDP) + (size_t)job * 4096;
  for (int idx = tid; idx < 4096; idx += 256) { B1[(idx >> 6) * 65 + (idx & 63)] = Qo[idx]; B2[(idx >> 6) * 65 + (idx & 63)] = So[idx]; }
  const float* nw = p.in[14] + l * 64;
  const size_t tokb = (size_t)b * T_ + t0;
  float pov[4][4], zv[4][4], nwv[4];
#pragma unroll
  for (int jj = 0; jj < 4; ++jj) nwv[jj] = nw[tj + 16 * jj];
#pragma unroll
  for (int ii = 0; ii < 4; ++ii)
#pragma unroll
    for (int jj = 0; jj < 4; ++jj) {
      const int t = ti + 16 * ii, e = tj + 16 * jj;
      pov[ii][jj] = Po[t * 64 + e];
      zv[ii][jj] = bf2f(proj[(tokb + t) * PW_ + 1800 + h * 64 + e]);
    }
  __builtin_amdgcn_sched_barrier(0);
  __syncthreads();
  float acc[4][4];
  {
    const int lane_ = tid & 63, wave_ = tid >> 6;
    const int i0 = (wave_ >> 1) * 32, j0 = (wave_ & 1) * 32, rb = i0 + 4 * (lane_ >> 5), cc = j0 + (lane_ & 31);
    float* Hs = sm + 8320;
    f32x16 am;
    ZERO16(am);
    mm64m<false, false>(B1, B2, am, i0, j0, lane_);
#pragma unroll
    for (int q = 0; q < 16; ++q) Hs[QROW(q) * 65 + cc] = am[q];
    __syncthreads();
#pragma unroll
    for (int ii = 0; ii < 4; ++ii)
#pragma unroll
      for (int jj = 0; jj < 4; ++jj) acc[ii][jj] = Hs[(ti + 16 * ii) * 65 + tj + 16 * jj];
  }
#pragma unroll
  for (int ii = 0; ii < 4; ++ii) {
    const int t = ti + 16 * ii;
    float ov[4]; float ss = 0.f;
#pragma unroll
    for (int jj = 0; jj < 4; ++jj) { ov[jj] = acc[ii][jj] + pov[ii][jj]; ss += ov[jj] * ov[jj]; }
    ss = row16_sum(ss);
    const float rs = rsqrtf(ss * (1.f / 64.f) + 1e-6f);
#pragma unroll
    for (int jj = 0; jj < 4; ++jj) {
      const int e = tj + 16 * jj;
      y[(tokb + t) * 1024 + 256 + h * 64 + e] = f2bf(ov[jj] * rs * nwv[jj] * siluf_(zv[ii][jj]));
    }
  }
  __syncthreads();
}

DEV void job_nsa_tok(const Params& p, int l, int job) {
  const int tid = opaque_tid(), lane = tid & 63, wave = tid >> 6;
  const int tok = job * 4 + wave, b = tok >> 13, t = tok & 8191;
  const u16* proj = (const u16*)(p.ws + OFF_PROJ);
  u16* qn = (u16*)(p.ws + OFF_QN);
  u16* ks = (u16*)(p.ws + OFF_KS);
  u16* kw = (u16*)(p.ws + OFF_KW);
  const float* qkn = p.in[15] + l * 256;
  const int i = lane & 31;
  const float inv = exp2f(-(float)i * (13.287712379549449f / 32.f));
  const float ang = (float)t * inv;
  const float sn = sinf(ang), cs = cosf(ang);
  float xv[12];
#pragma unroll
  for (int v = 0; v < 12; ++v) {
    const int col = v < 8 ? 2064 + v * 64 : (v < 10 ? 2064 + 512 + 2 * 128 + (v - 8) * 64 : 2064 + 512 + 4 * 128 + (v - 10) * 64);
    xv[v] = bf2f(proj[(size_t)tok * PW_ + col + lane]);
  }
#pragma unroll
  for (int v = 0; v < 12; ++v) {
    int wsel; u16* dst; float post = 1.f;
    if (v < 8) { wsel = 0; dst = qn + (((size_t)(b * 8 + v)) * T_ + t) * 64; post = 0.125f * 1.4426950408889634f; }
    else if (v < 10) { wsel = 2; dst = ks + (((size_t)(b * 2 + v - 8)) * T_ + t) * 64; }
    else { wsel = 3; dst = kw + (((size_t)(b * 2 + v - 10)) * T_ + t) * 64; }
    const float x = xv[v];
    const float ss = wave_sum(x * x);
    const float yv = x * rsqrtf(ss * (1.f / 64.f) + 1e-6f) * qkn[wsel * 64 + lane];
    const float o = __shfl_xor(yv, 32);
    const float out = lane < 32 ? yv * cs - o * sn : o * sn + yv * cs;
    dst[lane] = f2bf(out * post);
  }
}

DEV void job_nsa_vt(const Params& p, int job, unsigned char* smem) {
  const int tid = opaque_tid();
  const int tile = job & 127, bh = (job >> 7) & 3, which = job >> 9;
  const int b = bh >> 1, hkv = bh & 1, t0 = tile * 64;
  const u16* proj = (const u16*)(p.ws + OFF_PROJ);
  u16* vt = (u16*)(p.ws + (which == 0 ? OFF_VST : OFF_VWT));
  const int col = 2064 + 512 + (which == 0 ? 3 : 5) * 128 + hkv * 64;
  u16* sm = (u16*)smem;
  {
    const int rr = tid >> 2, seg = tid & 3;
    const uint4* s = (const uint4*)(proj + ((size_t)b * T_ + t0 + rr) * PW_ + col + seg * 16);
    uint4 a = s[0], bq = s[1];
    uint32_t* d = (uint32_t*)(sm + rr * 66 + seg * 16);
    d[0] = a.x; d[1] = a.y; d[2] = a.z; d[3] = a.w; d[4] = bq.x; d[5] = bq.y; d[6] = bq.z; d[7] = bq.w;
  }
  __syncthreads();
  {
    const int d = tid >> 2, seg = tid & 3;
    uint32_t w[8];
#pragma unroll
    for (int i = 0; i < 8; ++i) w[i] = (uint32_t)sm[(seg * 16 + 2 * i) * 66 + d] | ((uint32_t)sm[(seg * 16 + 2 * i + 1) * 66 + d] << 16);
    uint4* o = (uint4*)(vt + ((size_t)(b * 2 + hkv) * 64 + d) * T_ + t0 + seg * 16);
    o[0] = make_uint4(w[0], w[1], w[2], w[3]);
    o[1] = make_uint4(w[4], w[5], w[6], w[7]);
  }
  __syncthreads();
}

DEV void job_cmp2(const Params& p, int l, int job, float* sm) {
  const int tid = opaque_tid(), lane = tid & 63, wave = tid >> 6;
  const int wjob = job * 4 + wave, prob = wjob >> 9, n = wjob & 511;
  const int b = prob >> 2, hkv = (prob >> 1) & 1, kv = prob & 1;
  const u16* hid = (const u16*)(p.ws + OFF_HID) + ((size_t)prob * 512 + n) * 256;
  float* hrow = sm + wave * 256;
  {
    const uint2 hv = *(const uint2*)(hid + lane * 4);
    hrow[lane * 4 + 0] = bflo(hv.x); hrow[lane * 4 + 1] = bfhi(hv.x);
    hrow[lane * 4 + 2] = bflo(hv.y); hrow[lane * 4 + 3] = bfhi(hv.y);
  }
  __syncthreads();
  const float* w2 = p.in[18] + ((size_t)(l * 2 + kv)) * 256 * 64;
  float o = 0.f;
#pragma unroll 32
  for (int j = 0; j < 256; ++j) o += hrow[j] * w2[j * 64 + lane];
  if (n == 511) o = 0.f;
  if (kv == 0) {
    const float ss = wave_sum(o * o);
    const float yv = o * rsqrtf(ss * (1.f / 64.f) + 1e-6f) * p.in[15][l * 256 + 64 + lane];
    const int i = lane & 31;
    const float inv = exp2f(-(float)i * (13.287712379549449f / 32.f));
    const float ang = (float)(16 * n + 31) * inv;
    const float sn = sinf(ang), cs = cosf(ang);
    const float ot = __shfl_xor(yv, 32);
    float out = lane < 32 ? yv * cs - ot * sn : ot * sn + yv * cs;
    if (n == 511) out = 0.f;
    ((u16*)(p.ws + OFF_KC))[((size_t)(b * 2 + hkv) * 512 + n) * 64 + lane] = f2bf(out);
  } else {
    ((u16*)(p.ws + OFF_VCT))[((size_t)(b * 2 + hkv) * 64 + lane) * 512 + n] = f2bf(o);
  }
  __syncthreads();
}

template <int MODE, bool IMP>
DEV void nsa_loop(u16* Ks, u16* Vs, const u16* __restrict__ kb, const u16* __restrict__ vb, int vstride,
                  int ntile, int tile_lo, const int* tlist, const bf16x8 (&qf)[4], int t, int t0, int c, int h,
                  float& m, float& lsum, f32x16 (&acc)[2], uint32_t sw0, uint32_t sw1, uint32_t sw2, uint32_t sw3,
                  float* imp, int tl, float inv_l) {
  const int tid = opaque_tid();
  uint4 rk0, rk1, rv0, rv1;
  const int lrow0 = tid >> 3, lpart = tid & 7, lrow1 = lrow0 + 32;
#define TILEID(idx_) (MODE == 1 ? tlist[idx_] : tile_lo + (idx_))
#define NGLOAD(tix_)                                                                     \
  {                                                                                      \
    const int key0_ = (tix_) * 64;                                                       \
    rk0 = *(const uint4*)(kb + (size_t)(key0_ + lrow0) * 64 + lpart * 8);                \
    rk1 = *(const uint4*)(kb + (size_t)(key0_ + lrow1) * 64 + lpart * 8);                \
    if (!IMP) {                                                                          \
      rv0 = *(const uint4*)(vb + (size_t)lrow0 * vstride + key0_ + lpart * 8);           \
      rv1 = *(const uint4*)(vb + (size_t)lrow1 * vstride + key0_ + lpart * 8);           \
    }                                                                                    \
  }
#define NSSTORE(buf_)                                                                    \
  {                                                                                      \
    *(uint4*)(Ks + ((buf_) * 64 + lrow0) * 72 + lpart * 8) = rk0;                        \
    *(uint4*)(Ks + ((buf_) * 64 + lrow1) * 72 + lpart * 8) = rk1;                        \
    if (!IMP) {                                                                          \
      *(uint4*)(Vs + ((buf_) * 64 + lrow0) * 72 + lpart * 8) = rv0;                      \
      *(uint4*)(Vs + ((buf_) * 64 + lrow1) * 72 + lpart * 8) = rv1;                      \
    }                                                                                    \
  }
  NGLOAD(TILEID(0));
  NSSTORE(0);
  __syncthreads();
  for (int idx = 0; idx < ntile; ++idx) {
    const int buf = idx & 1;
    const int tix = TILEID(idx);
    const int key0 = tix * 64;
    if (idx + 1 < ntile) NGLOAD(TILEID(idx + 1));
    __builtin_amdgcn_sched_barrier(0);
    bool tv = true;
    if (MODE == 1) {
      const int w = tix >> 5;
      const uint32_t sw = w == 0 ? sw0 : (w == 1 ? sw1 : (w == 2 ? sw2 : sw3));
      tv = (sw >> (tix & 31)) & 1u;
    }
    const bool wave_any = (MODE != 1) || (__builtin_amdgcn_ballot_w64(tv) != 0ull);
    if (wave_any) {
    f32x16 s[2];
#pragma unroll
    for (int kt = 0; kt < 2; ++kt) {
#pragma unroll
      for (int i = 0; i < 16; ++i) s[kt][i] = 0.f;
#pragma unroll
      for (int ks = 0; ks < 4; ++ks) {
        const bf16x8 a = *(const bf16x8*)(Ks + (buf * 64 + kt * 32 + c) * 72 + ks * 16 + 8 * h);
        s[kt] = __builtin_amdgcn_mfma_f32_32x32x16_bf16(a, qf[ks], s[kt], 0, 0, 0);
      }
    }
    bool need_mask;
    if (MODE == 0) need_mask = !(16 * (key0 + 63) + 31 <= t0);
    else if (MODE == 1) need_mask = (key0 + 63 > t0);
    else need_mask = !((key0 + 63 <= t0) && (key0 + 512 > t0 + 31));
    if (IMP) need_mask = true;
    float mx = -1e30f;
    if (need_mask) {
#pragma unroll
      for (int kt = 0; kt < 2; ++kt)
#pragma unroll
        for (int i = 0; i < 16; ++i) {
          const int key = key0 + kt * 32 + (i & 3) + 8 * (i >> 2) + 4 * h;
          bool v;
          if (MODE == 0) v = (16 * key + 31 <= t);
          else if (MODE == 1) v = tv && (key <= t);
          else v = (key <= t) && (key + 512 > t);
          const float sv = v ? s[kt][i] : -1e30f;
          s[kt][i] = sv;
          mx = fmaxf(mx, sv);
        }
    } else {
#pragma unroll
      for (int kt = 0; kt < 2; ++kt)
#pragma unroll
        for (int i = 0; i < 16; ++i) mx = fmaxf(mx, s[kt][i]);
      if (MODE == 1 && !tv) mx = -1e30f;
    }
    if (!IMP) {
      mx = fmaxf(mx, __shfl_xor(mx, 32));
      const bool grew = __builtin_amdgcn_ballot_w64(mx > m + 8.0f) != 0ull;
      float mn = m, alpha = 1.f;
      if (grew) { mn = fmaxf(m, mx); alpha = __builtin_amdgcn_exp2f(m - mn); m = mn; }
      float ps = 0.f;
      if (need_mask) {
#pragma unroll
        for (int kt = 0; kt < 2; ++kt)
#pragma unroll
          for (int i = 0; i < 16; ++i) {
            const float pv = s[kt][i] > -1e29f ? __builtin_amdgcn_exp2f(s[kt][i] - mn) : 0.f;
            s[kt][i] = pv; ps += pv;
          }
      } else {
        const float msub = (MODE == 1 && !tv) ? 1e30f : mn;
#pragma unroll
        for (int kt = 0; kt < 2; ++kt)
#pragma unroll
          for (int i = 0; i < 16; ++i) {
            const float pv = __builtin_amdgcn_exp2f(s[kt][i] - msub);
            s[kt][i] = pv; ps += pv;
          }
      }
      lsum = lsum * alpha + ps;
      if (grew) {
#pragma unroll
        for (int i = 0; i < 16; ++i) { acc[0][i] *= alpha; acc[1][i] *= alpha; }
      }
#pragma unroll
      for (int kt = 0; kt < 2; ++kt)
#pragma unroll
        for (int s2 = 0; s2 < 2; ++s2) {
          union { u32x4 u; bf16x8 v; } pf;
          pf.u[0] = cvtpk(s[kt][8 * s2 + 0], s[kt][8 * s2 + 1]);
          pf.u[1] = cvtpk(s[kt][8 * s2 + 2], s[kt][8 * s2 + 3]);
          pf.u[2] = cvtpk(s[kt][8 * s2 + 4], s[kt][8 * s2 + 5]);
          pf.u[3] = cvtpk(s[kt][8 * s2 + 6], s[kt][8 * s2 + 7]);
#pragma unroll
          for (int dt = 0; dt < 2; ++dt) {
            const u16* vp = Vs + (buf * 64 + dt * 32 + c) * 72 + kt * 32 + 16 * s2 + 4 * h;
            const uint2 lo = *(const uint2*)vp;
            const uint2 hi = *(const uint2*)(vp + 8);
            union { u32x4 u; bf16x8 v; } af;
            af.u[0] = lo.x; af.u[1] = lo.y; af.u[2] = hi.x; af.u[3] = hi.y;
            acc[dt] = __builtin_amdgcn_mfma_f32_32x32x16_bf16(af.v, pf.v, acc[dt], 0, 0, 0);
          }
        }
    } else {
#pragma unroll
      for (int kt = 0; kt < 2; ++kt)
#pragma unroll
        for (int q4 = 0; q4 < 4; ++q4) {
          float pr[4];
#pragma unroll
          for (int e = 0; e < 4; ++e) {
            const float sv = s[kt][4 * q4 + e];
            pr[e] = sv > -1e29f ? __builtin_amdgcn_exp2f(sv - m) * inv_l : 0.f;
          }
          float a = pr[0] + pr[1] + pr[2] + 0.5f * pr[3];
          float bq = 0.5f * pr[3];
          a += dpp_f(a, 0); a += dpp_f(a, 1);
          bq += dpp_f(bq, 0); bq += dpp_f(bq, 1);
          if ((c & 3) == 0) {
            const int mi = (key0 + kt * 32 + 8 * q4 + 4 * h) >> 2;
            atomicAdd(&imp[tl * 129 + mi], a);
            if (mi + 1 < 128) atomicAdd(&imp[tl * 129 + mi + 1], bq);
          }
        }
    }
    }
    if (idx + 1 < ntile) NSSTORE(buf ^ 1);
    __syncthreads();
  }
#undef TILEID
#undef NGLOAD
#undef NSSTORE
}

template <bool FIRST>
DEV void nsa_emit(u16* y, f32x16 (&acc)[2], int h) {
  if (FIRST) {
    typedef __attribute__((ext_vector_type(2))) unsigned u32x2_;
#pragma unroll
    for (int dt = 0; dt < 2; ++dt)
#pragma unroll
      for (int i4 = 0; i4 < 4; i4 += 2) {
        uint32_t ax = pack2(acc[dt][4 * i4 + 0], acc[dt][4 * i4 + 1]), ay = pack2(acc[dt][4 * i4 + 2], acc[dt][4 * i4 + 3]);
        uint32_t bx = pack2(acc[dt][4 * i4 + 4], acc[dt][4 * i4 + 5]), by = pack2(acc[dt][4 * i4 + 6], acc[dt][4 * i4 + 7]);
        const u32x2_ rx = __builtin_amdgcn_permlane32_swap(ax, bx, false, false);
        const u32x2_ ry = __builtin_amdgcn_permlane32_swap(ay, by, false, false);
        *(uint4*)(y + dt * 32 + 8 * i4 + (h ? 8 : 0)) = make_uint4(rx[0], ry[0], rx[1], ry[1]);
      }
  } else {
#pragma unroll
    for (int dt = 0; dt < 2; ++dt)
#pragma unroll
      for (int i4 = 0; i4 < 4; ++i4) {
        const int d = dt * 32 + 8 * i4 + 4 * h;
        float v0 = acc[dt][4 * i4 + 0], v1 = acc[dt][4 * i4 + 1], v2 = acc[dt][4 * i4 + 2], v3 = acc[dt][4 * i4 + 3];
        const uint2 o = *(const uint2*)(y + d);
        v0 += bflo(o.x); v1 += bfhi(o.x); v2 += bflo(o.y); v3 += bfhi(o.y);
        *(uint2*)(y + d) = make_uint2(pack2(v0, v1), pack2(v2, v3));
      }
  }
#pragma unroll
  for (int i = 0; i < 16; ++i) { acc[0][i] = 0.f; acc[1][i] = 0.f; }
}

DEV void job_nsa_attn(const Params& p, int l, int job, unsigned char* smem) {
  const int tid = opaque_tid(), lane = tid & 63, wave = tid >> 6;
  const int c = lane & 31, h = lane >> 5;
  const int tile = 255 - (job >> 2), bh = job & 3, b = bh >> 1, hkv = bh & 1;
  const int t0 = tile * 32, cur = t0 >> 6;
  const int tl = wave * 8 + (c >> 2), g = c & 3, head = hkv * 4 + g;
  const int t = t0 + tl;
  const size_t tok = (size_t)b * T_ + t;
  u16* Ks = (u16*)smem;
  u16* Vs = Ks + 2 * 64 * 72;
  float* imp = (float*)(smem + 36864);
  uint32_t* selm = (uint32_t*)(smem + 36864 + 16512);
  int* tlist = (int*)(smem + 36864 + 16512 + 512);
  int* misc = tlist + 128;
  uint32_t* unim = (uint32_t*)(misc + 4);
  const u16* qn = (const u16*)(p.ws + OFF_QN);
  const u16* qptr = qn + (((size_t)(b * 8 + head)) * T_ + t) * 64;
  bf16x8 qf[4];
#pragma unroll
  for (int ks = 0; ks < 4; ++ks) qf[ks] = *(const bf16x8*)(qptr + ks * 16 + 8 * h);
  const float* sd = (const float*)(p.ws + OFF_SIDE) + tok * 40 + 16;
  const float g0 = sigmoidf_(sd[head]), g1 = sigmoidf_(sd[8 + head]), g2 = sigmoidf_(sd[16 + head]);
  f32x16 acc[2];
#pragma unroll
  for (int i = 0; i < 16; ++i) { acc[0][i] = 0.f; acc[1][i] = 0.f; }
  u16* y = (u16*)(p.ws + OFF_HB) + tok * 1024 + 512 + head * 64;
  const int bk = b * 2 + hkv;
  const u16* kc = (const u16*)(p.ws + OFF_KC) + (size_t)bk * 512 * 64;
  const u16* vct = (const u16*)(p.ws + OFF_VCT) + (size_t)bk * 64 * 512;
  const int ncmp = (t0 >> 10) + 1;
  float m = -1e30f, ls = 0.f;
  nsa_loop<0, false>(Ks, Vs, kc, vct, 512, ncmp, 0, tlist, qf, t, t0, c, h, m, ls, acc, 0u, 0u, 0u, 0u, imp, tl, 0.f);
  {
    const float lt = ls + __shfl_xor(ls, 32);
    const float inv = lt > 0.f ? 1.f / lt : 0.f;
    const float f = g0 * inv;
#pragma unroll
    for (int i = 0; i < 16; ++i) { acc[0][i] *= f; acc[1][i] *= f; }
    nsa_emit<true>(y, acc, h);
    int ntl;
    if (cur >= 16) {
      for (int idx = tid; idx < 32 * 129; idx += 256) imp[idx] = 0.f;
      if (tid < 128) selm[tid] = 0u;
      __syncthreads();
      float dm = 0.f;
      nsa_loop<0, true>(Ks, Vs, kc, vct, 512, ncmp, 0, tlist, qf, t, t0, c, h, m, dm, acc, 0u, 0u, 0u, 0u, imp, tl, inv);
      {
        const int hiC = cur - 2;
        float v1[8], v2[8];
        uint32_t mk[8][4];
#pragma unroll
        for (int q = 0; q < 8; ++q) {
          const float* row = imp + (wave * 8 + q) * 129;
          v1[q] = (lane >= 1 && lane <= hiC) ? row[lane] : -1.f;
          v2[q] = (lane + 64 <= hiC) ? row[lane + 64] : -1.f;
          mk[q][0] = 1u; mk[q][1] = 0u; mk[q][2] = 0u; mk[q][3] = 0u;
        }
        for (int rnd = 0; rnd < 13; ++rnd) {
          float wm[8];
#pragma unroll
          for (int q = 0; q < 8; ++q) wm[q] = fmaxf(v1[q], v2[q]);
#pragma unroll
          for (int q = 0; q < 8; ++q) wm[q] = wave_max_valu(wm[q]);
#pragma unroll
          for (int q = 0; q < 8; ++q) {
            const unsigned long long bl1 = __builtin_amdgcn_ballot_w64(v1[q] == wm[q]);
            const unsigned long long bl2 = __builtin_amdgcn_ballot_w64(v2[q] == wm[q]);
            int selj;
            if (bl1 != 0ull) { const int ow = __builtin_ctzll(bl1); if (lane == ow) v1[q] = -1.f; selj = ow; }
            else { const int ow = __builtin_ctzll(bl2); if (lane == ow) v2[q] = -1.f; selj = ow + 64; }
            const uint32_t bit = 1u << (selj & 31);
            const int wsel = selj >> 5;
            mk[q][0] |= wsel == 0 ? bit : 0u; mk[q][1] |= wsel == 1 ? bit : 0u;
            mk[q][2] |= wsel == 2 ? bit : 0u; mk[q][3] |= wsel == 3 ? bit : 0u;
          }
        }
        if (lane == 0) {
#pragma unroll
          for (int q = 0; q < 8; ++q) {
            uint32_t f0 = mk[q][0], f1 = mk[q][1], f2 = mk[q][2], f3 = mk[q][3];
#pragma unroll
            for (int z = 0; z < 2; ++z) {
              const int jf = cur - z; const uint32_t bit = 1u << (jf & 31); const int wsel = jf >> 5;
              f0 |= wsel == 0 ? bit : 0u; f1 |= wsel == 1 ? bit : 0u; f2 |= wsel == 2 ? bit : 0u; f3 |= wsel == 3 ? bit : 0u;
            }
            uint32_t* sp = selm + (wave * 8 + q) * 4;
            sp[0] = f0; sp[1] = f1; sp[2] = f2; sp[3] = f3;
          }
        }
      }
      __syncthreads();
      if (tid < 4) unim[tid] = 0u;
      __syncthreads();
      if (tid < 128) atomicOr(&unim[tid & 3], selm[tid]);
      __syncthreads();
      if (tid < 128) {
        const uint32_t u0 = unim[0], u1 = unim[1], u2 = unim[2], u3 = unim[3];
        const int j = tid, w = j >> 5;
        const uint32_t uw = w == 0 ? u0 : (w == 1 ? u1 : (w == 2 ? u2 : u3));
        const int below = (w > 0 ? __popc(u0) : 0) + (w > 1 ? __popc(u1) : 0) + (w > 2 ? __popc(u2) : 0) + __popc(uw & ((1u << (j & 31)) - 1u));
        if (j <= cur && ((uw >> (j & 31)) & 1u)) tlist[below] = j;
        if (j == 0) misc[0] = __popc(u0) + __popc(u1) + __popc(u2) + __popc(u3);
      }
      __syncthreads();
      ntl = misc[0];
    } else {
      if (tid < 128) { tlist[tid] = tid; selm[tid] = 0xffffffffu; }
      __syncthreads();
      ntl = cur + 1;
    }
    const uint32_t sw0 = selm[tl * 4 + 0], sw1 = selm[tl * 4 + 1], sw2 = selm[tl * 4 + 2], sw3 = selm[tl * 4 + 3];
    const u16* ksb = (const u16*)(p.ws + OFF_KS) + (size_t)bk * T_ * 64;
    const u16* vsb = (const u16*)(p.ws + OFF_VST) + (size_t)bk * 64 * T_;
    m = -1e30f; ls = 0.f;
    nsa_loop<1, false>(Ks, Vs, ksb, vsb, T_, ntl, 0, tlist, qf, t, t0, c, h, m, ls, acc, sw0, sw1, sw2, sw3, imp, tl, 0.f);
    {
      const float lt2 = ls + __shfl_xor(ls, 32);
      const float f2 = g1 / lt2;
#pragma unroll
      for (int i = 0; i < 16; ++i) { acc[0][i] *= f2; acc[1][i] *= f2; }
      nsa_emit<false>(y, acc, h);
    }
  }
  {
    const u16* kwb = (const u16*)(p.ws + OFF_KW) + (size_t)bk * T_ * 64;
    const u16* vwb = (const u16*)(p.ws + OFF_VWT) + (size_t)bk * 64 * T_;
    const int lo = (t0 - 511 > 0 ? t0 - 511 : 0) >> 6;
    m = -1e30f; ls = 0.f;
    nsa_loop<2, false>(Ks, Vs, kwb, vwb, T_, cur - lo + 1, lo, tlist, qf, t, t0, c, h, m, ls, acc, 0u, 0u, 0u, 0u, imp, tl, 0.f);
    const float lt3 = ls + __shfl_xor(ls, 32);
    const float f3 = g2 / lt3;
#pragma unroll
    for (int i = 0; i < 16; ++i) { acc[0][i] *= f3; acc[1][i] *= f3; }
    nsa_emit<false>(y, acc, h);
  }
  __syncthreads();
}


#define XB_TMO      128
#define XB_XCNT(j)  (256  + 64 * (j))
#define XB_XSUB(j)  (1280 + 64 * (j))
#define XB_XGEN(j)  (2304 + 64 * (j))
#define XB_TOP      3328
#define XB_TOPGEN   3392
#define XCD_BAR_WORDS 3456
#define XB_RANKW(j) (3456 + 64 * (j))
#define XB_ALL_WORDS (3456 + 64 * 16 + 64 * 6)
#define XB_QUEUE(k) (3456 + 64 * 16 + 64 * (k))
#define XB_SPIN_CAP (1u << 18)
#define LAS __attribute__((address_space(3)))
DEV unsigned xb_ld(unsigned* p)              { return __hip_atomic_load(p, __ATOMIC_RELAXED, __HIP_MEMORY_SCOPE_AGENT); }
DEV unsigned xb_add(unsigned* p, unsigned v) { return __hip_atomic_fetch_add(p, v, __ATOMIC_RELAXED, __HIP_MEMORY_SCOPE_AGENT); }
DEV unsigned xb_xcc_id() { return (unsigned)__builtin_amdgcn_s_getreg((3 << 11) | 20) & 0xFu; }
#define XB_SPIN(cond, bar) do { unsigned _sp = 0; while (cond) { __builtin_amdgcn_s_sleep(1); \
    if ((++_sp & 255u) == 0u) { if (xb_ld(&(bar)[XB_TMO])) break; if (_sp > XB_SPIN_CAP) { atomicAdd(&(bar)[XB_TMO], 1u); break; } } } } while (0)
struct XcdBarrier { unsigned* bar; unsigned x; volatile LAS unsigned* st; };
DEV XcdBarrier xcd_barrier_post(unsigned* bar, volatile LAS unsigned* st) {
  XcdBarrier b; b.bar = bar; b.x = xb_xcc_id(); b.st = st;
  if (threadIdx.x == 0) (void)xb_add(&bar[XB_XCNT(b.x)], 1u);
  return b;
}
DEV void xcd_barrier_complete(unsigned* bar, unsigned x, unsigned& nloc, unsigned& nx) {
  const unsigned G = gridDim.x * gridDim.y * gridDim.z;
  unsigned sum, cnt, mine, sp = 0u;
  for (;;) {
    sum = 0u; cnt = 0u; mine = 0u;
#pragma unroll
    for (unsigned j = 0; j < 16; ++j) { const unsigned c = xb_ld(&bar[XB_XCNT(j)]); sum += c; cnt += (c > 0u) ? 1u : 0u; mine = (j == x) ? c : mine; }
    if (sum == G) break;
    __builtin_amdgcn_s_sleep(1);
    if ((++sp & 255u) == 0u) { if (xb_ld(&bar[XB_TMO])) break; if (sp > XB_SPIN_CAP) { atomicAdd(&bar[XB_TMO], 1u); break; } }
  }
  nloc = mine > 0u ? mine : 1u; nx = cnt > 0u ? cnt : 1u;
}
DEV void xcd_barrier(const XcdBarrier& b) {
  asm volatile("s_waitcnt vmcnt(0)" ::: "memory");
  __syncthreads();
  if (threadIdx.x == 0) {
    unsigned* bar = b.bar;
    __builtin_amdgcn_s_waitcnt(0);
    unsigned nloc = b.st[0], nx = b.st[1];
    if (nloc == 0u) { xcd_barrier_complete(bar, b.x, nloc, nx); b.st[0] = nloc; b.st[1] = nx; }
    const unsigned old = xb_add(&bar[XB_XSUB(b.x)], 1u);
    const unsigned gen = old / nloc;
    if (old + 1u == (gen + 1u) * nloc) {
      __builtin_amdgcn_fence(__ATOMIC_RELEASE, "agent");
      asm volatile("s_waitcnt vmcnt(0)" ::: "memory");
      const unsigned og = xb_add(&bar[XB_TOP], 1u);
      const unsigned tg = og / nx;
      if (og + 1u == (tg + 1u) * nx) xb_add(&bar[XB_TOPGEN], 1u);
      else XB_SPIN(xb_ld(&bar[XB_TOPGEN]) == tg, bar);
      __builtin_amdgcn_fence(__ATOMIC_ACQUIRE, "agent");
      xb_add(&bar[XB_XGEN(b.x)], 1u);
      asm volatile("s_waitcnt vmcnt(0)" ::: "memory");
    } else {
      XB_SPIN(xb_ld(&bar[XB_XGEN(b.x)]) == gen, bar);
      __builtin_amdgcn_fence(__ATOMIC_ACQUIRE, "agent");
      asm volatile("s_waitcnt vmcnt(0)" ::: "memory");
    }
  }
  __syncthreads();
}

DEV void wt_ffn_job(const Params& p, int l, int f, int j, float* smf) {
  u16* wt = (u16*)(p.ws + (f == 0 ? OFF_WT : OFF_WTC));
  if (j < 1408) {
    const int rt = j >> 4, ktile = j & 15;
    job_wt(p.in[5] + (size_t)(l * 2 + f) * 1024 * 5632, 5632, wt + WT_UP / 2, 1024, ktile * 64, rt * 64, 1, 0, smf);
  } else {
    const int jj = j - 1408, rt = jj / 44, ktile = jj % 44;
    job_wt(p.in[6] + (size_t)(l * 2 + f) * 2816 * 1024, 1024, wt + WT_DOWN / 2, 2816, ktile * 64, rt * 64, 0, 1024, smf);
  }
}
DEV void wt_mix_job(const Params& p, int l, int j, float* smf) {
  u16* wt = (u16*)(p.ws + OFF_WTB);
  if (j < 864) {
    const int rt = j >> 4, ktile = j & 15;
    job_wt(p.in[7] + (size_t)l * 1024 * INW_, INW_, wt + WT_IN / 2, 1024, ktile * 64, rt * 64, 0, INW_, smf);
  } else if (j < 864 + 256) {
    const int jj = j - 864, rt = jj >> 4, ktile = jj & 15;
    job_wt(p.in[8] + (size_t)l * 1024 * 1024, 1024, wt + WT_OUT / 2, 1024, ktile * 64, rt * 64, 0, 1024, smf);
  } else {
    const int jj = j - 1120, kv = jj >> 7, q = jj & 127, rt = q >> 5, ktile = q & 31;
    job_wt(p.in[17] + (size_t)(l * 2 + kv) * 2048 * 256, 256, wt + WT_W1 / 2 + (size_t)kv * 256 * 2048, 2048, ktile * 64, rt * 64, 0, 256, smf);
  }
}

#define GEMM_TILE_LOOP(NT_, BODY)                                                         \
  {                                                                                       \
    if (bid >= (nb >> 1)) __builtin_amdgcn_s_sleep(13);     \
    const int sn4_ = ((NT_) + 3) >> 2;                                                    \
    const int totS_ = 16 * sn4_;                                                          \
    const int nloc_ = (int)xb.st[0], nx_ = (int)xb.st[1], rank_ = (int)xb.st[2], x_ = (int)xb.x; \
    if (nx_ == 8 && x_ < 8 && (totS_ & 7) == 0 && nloc_ > 0) {                            \
      const int cnt_ = totS_ >> 3, s0_ = x_ * cnt_;                                       \
      for (int o_ = rank_; o_ < cnt_ * 32; o_ += nloc_) {                                 \
        const int S_ = s0_ + (o_ >> 5), w_ = o_ & 31;                                     \
        const int mt_ = (S_ / sn4_) * 8 + (w_ >> 2), nt_ = (S_ % sn4_) * 4 + (w_ & 3);    \
        if (nt_ < (NT_)) { BODY; }                                                        \
      }                                                                                   \
    } else {                                                                              \
      for (int j_ = bid; j_ < 128 * (NT_); j_ += nb) { const int mt_ = j_ / (NT_), nt_ = j_ % (NT_); BODY; } \
    }                                                                                     \
  }

#define DYN_LOOP(QI_, NJOBS_, ...)                                                       \
  for (;;) {                                                                             \
    if (threadIdx.x == 0) xb.st[3] = atomicAdd(&barw[XB_QUEUE(QI_)], 1u);                \
    __syncthreads();                                                                     \
    const int j = (int)xb.st[3];                                                         \
    __syncthreads();                                                                     \
    if (j >= (NJOBS_)) break;                                                            \
    __VA_ARGS__                                                                          \
  }

__global__ void __launch_bounds__(256, 2) fwd_megakernel(Params p) {
  extern __shared__ __attribute__((aligned(16))) unsigned char smem[];
  float* smf = (float*)smem;
  cg::grid_group grid = cg::this_grid();
  const int nb = gridDim.x, bid = blockIdx.x;
  float* mod = (float*)(p.ws + OFF_MOD);
  u16* hb = (u16*)(p.ws + OFF_HB);
  u16* wtb = (u16*)(p.ws + OFF_WTB);
  u16* act = (u16*)(p.ws + OFF_ACT);
  u16* proj = (u16*)(p.ws + OFF_PROJ);
  float* side = (float*)(p.ws + OFF_SIDE);

  unsigned* barw = (unsigned*)(p.ws + OFF_BAR);
  if (bid == nb - 1) { for (int i = threadIdx.x; i < XB_ALL_WORDS; i += 256) barw[i] = 0u; }
  if (threadIdx.x == 0) { ((volatile unsigned*)(smem + LDS_BYTES - 16))[0] = 0u; ((volatile unsigned*)(smem + LDS_BYTES - 16))[1] = 0u; }
  for (int j = bid; j < 288 + 16; j += nb) { if (j < 288) job_mod(p, j, smf); else job_bias1(p, j - 288, smf); }
  {
    const int nconv = 2112 + 1376;
    if (nb > 304 && bid >= 304) {
      const int nw_ = nb - 304, share = (nconv * 5 / 6) / nw_;
      for (int k = 0; k < share; ++k) { const int cj = (bid - 304) + nw_ * k; if (cj < 2112) wt_ffn_job(p, 0, 0, cj, smf); else wt_mix_job(p, 0, cj - 2112, smf); }
      for (int cj = nw_ * share + bid; cj < nconv; cj += nb) { if (cj < 2112) wt_ffn_job(p, 0, 0, cj, smf); else wt_mix_job(p, 0, cj - 2112, smf); }
    } else {
      const int nw_ = nb > 304 ? nb - 304 : 0, share = nw_ > 0 ? (nconv * 5 / 6) / nw_ : 0;
      for (int cj = nw_ * share + bid; cj < nconv; cj += nb) { if (cj < 2112) wt_ffn_job(p, 0, 0, cj, smf); else wt_mix_job(p, 0, cj - 2112, smf); }
    }
  }
  grid.sync();
  const XcdBarrier xb = xcd_barrier_post(barw, (volatile LAS unsigned*)(smem + LDS_BYTES - 16));
  if (threadIdx.x == 0) xb.st[2] = xb_add(&barw[XB_RANKW(xb.x)], 1u);
#define GSYNC() xcd_barrier(xb)

  for (int l = 0; l < 2; ++l) {
    const float* modl = mod + l * 2 * 9216;
    const float* nwl = p.in[4] + l * 3 * 1024;
    for (int f = 0; f < 2; ++f) {
      if (f == 1) {
        for (int j = bid; j < 4096; j += nb) job_adaln(p.out, nwl + 1024, modl, 1, hb, j);
        GSYNC();
        {
          ALplain al{hb, 1024};
          EpiIn epi{proj, side};
          GEMM_TILE_LOOP(27, gemm_tile(smem, al, wtb + WT_IN / 2, 1024, 16, epi, mt_ * 128, nt_ * 128));
        }
        GSYNC();
        DYN_LOOP(l * 2 + 0, 64 + 1024 + 1024 + 640, {
          if (j >= 2112) {
            for (int jl = 2112 + (j - 2112) * 8, je = jl + 8; jl < je; ++jl) {
              if (jl < 6208) job_nsa_tok(p, l, jl - 2112);
              else job_nsa_vt(p, jl - 6208, smem);
            }
          } else
          if (j >= 64 && j < 1088) { SK_GDNPREP(job_gdn_prep(p, l, j - 64, smf);) }
          else if (j < 64) {
            const int q = j, prob = q >> 3, mt = (q >> 1) & 3, nt = q & 1;
            const int b = prob >> 2, hkv = (prob >> 1) & 1, kv = prob & 1;
            ALcmp al{proj + (size_t)b * T_ * PW_ + 2576 + kv * 128 + hkv * 64};
            EpiHid epi{(u16*)(p.ws + OFF_HID) + (size_t)prob * 512 * 256, (const float*)(p.ws + OFF_B1) + (l * 2 + kv) * 256};
            gemm_tile(smem, al, wtb + WT_W1 / 2 + (size_t)kv * 256 * 2048, 2048, 32, epi, mt * 128, nt * 128);
          }
          else if (j < 2112) { SK_MLPREP(job_ml_prep(p, l, j - 1088, smf);) }
        })
        GSYNC();
        DYN_LOOP(4 + l, 128 + 136 + 1024 + 2112 + (l == 0 ? 2112 : 0), {
          if (j < 128) { SK_GDNSCAN(job_gdn_scan(p, j, smf);) }
          else if (j < 264) job_ml_scan(p, j - 128);
          else if (j < 1288) job_cmp2(p, l, j - 264, smf);
          else if (j < 3400) wt_ffn_job(p, l, 1, j - 1288, smf);
          else wt_ffn_job(p, 1, 0, j - 3400, smf);
        })
        GSYNC();
        DYN_LOOP(l * 2 + 1, 3072, {
          if (j < 1024) { SK_NSA(job_nsa_attn(p, l, j, smem);) }
          else if (j < 2048) { SK_MLOUT(job_ml_out(p, l, j - 1024, smf);) }
          else { SK_GDNOUT(job_gdn_out(p, l, j - 2048, smf);) }
        })
        GSYNC();
        {
          ALplain al{hb, 1024};
          EpiRes epi{p.out, p.out, modl + 5 * 1024, 1.0f};
          GEMM_TILE_LOOP(8, gemm_tile(smem, al, wtb + WT_OUT / 2, 1024, 16, epi, mt_ * 128, nt_ * 128));
        }
        GSYNC();
      }
      const int sub = f * 2;
      const float* xsrc = (l == 0 && f == 0) ? p.in[0] : p.out;
      for (int j = bid; j < 4096 + ((l == 0 && f == 1) ? 1376 : 0); j += nb) {
        if (j < 4096) job_adaln(xsrc, nwl + sub * 1024, modl, sub, hb, j);
        else wt_mix_job(p, 1, j - 4096, smf);
      }
      GSYNC();
      u16* wt = (u16*)(p.ws + (f == 0 ? OFF_WT : OFF_WTC));
      {
        ALplain al{hb, 1024};
        EpiUp epi{act};
        GEMM_TILE_LOOP(44, gemm_tile(smem, al, wt + WT_UP / 2, 1024, 16, epi, mt_ * 128, nt_ * 128));
      }
      GSYNC();
      {
        ALplain al{act, DFF_};
        EpiRes epi{xsrc, p.out, modl + (3 * sub + 2) * 1024, 0.5f};
        GEMM_TILE_LOOP(8, gemm_tile(smem, al, wt + WT_DOWN / 2, DFF_, 44, epi, mt_ * 128, nt_ * 128));
      }
      GSYNC();
    }
  }
}

extern "C" void kernel_launch(void* const* d_in, const int* in_sizes, int n_in, void* d_out, int out_size, void* d_ws, size_t ws_size, hipStream_t stream) {
  static int grid_blocks = 0;
  if (!grid_blocks) {
    int dev = 0, cus = 0, per_cu = 0;
    hipGetDevice(&dev);
    hipDeviceGetAttribute(&cus, hipDeviceAttributeMultiprocessorCount, dev);
    hipFuncSetAttribute((const void*)fwd_megakernel, hipFuncAttributeMaxDynamicSharedMemorySize, LDS_BYTES);
    hipOccupancyMaxActiveBlocksPerMultiprocessor(&per_cu, (const void*)fwd_megakernel, 256, LDS_BYTES);
    if (per_cu < 1) per_cu = 1;
    if (per_cu > 2) per_cu = 2;
    grid_blocks = cus * per_cu;
    if (ws_size < OFF_END) fprintf(stderr, "kernel_launch: workspace too small: %zu < %zu\n", ws_size, (size_t)OFF_END);
  }
  Params p{};
  for (int i = 0; i < 19; ++i) p.in[i] = (const float*)d_in[i];
  p.out = (float*)d_out;
  p.ws = (unsigned char*)d_ws;
  void* args[] = {&p};
  hipError_t e = hipLaunchCooperativeKernel((const void*)fwd_megakernel, dim3(grid_blocks), dim3(256), args, LDS_BYTES, stream);
  if (e != hipSuccess) fprintf(stderr, "cooperative launch failed: %s (grid %d)\n", hipGetErrorString(e), grid_blocks);
}
```
